# Optimizing an MI355X kernel written in HIP

```python
import jax, jax.numpy as jnp
from jax import lax
import numpy as np

D_MODEL = 1024
BATCH = 32
SEQ = 2048
DEPTH = 2
DEC_BATCH = 16
DEC_SEQ = 64
PAST_LEN = 2048

CHUNK = 64
HEAD_DIM = 64
N_HEADS = (D_MODEL // 2) // HEAD_DIM
ATT_DIM = N_HEADS * HEAD_DIM
CONV_DIM = D_MODEL // 2
CONV_W = 3
MIX_DIM = ATT_DIM + CONV_DIM
IN_DIM = 4 * ATT_DIM + N_HEADS + 4 * CONV_DIM
SPLIT_POINTS = (ATT_DIM, 2 * ATT_DIM, 3 * ATT_DIM, 4 * ATT_DIM, 4 * ATT_DIM + N_HEADS,
                4 * ATT_DIM + N_HEADS + CONV_DIM, 4 * ATT_DIM + N_HEADS + 2 * CONV_DIM,
                4 * ATT_DIM + N_HEADS + 3 * CONV_DIM)
Q_BLOCK = 128
ATTN_SCALE = HEAD_DIM ** -0.5
EPS = 1e-6
NEG = -1e30

kernel_name = "fox_shortconv_parallel_hybrid_step"


def rmsnorm(x, g):
    xf = x.astype(jnp.float32)
    y = xf * lax.rsqrt(jnp.mean(xf * xf, axis=-1, keepdims=True) + EPS)
    return (y * g.astype(jnp.float32)).astype(x.dtype)


def fox_attention(q, k, v, c_q, c_k, q_pos, k_pos):
    s = jnp.einsum('bqhd,bkhd->bhqk', q, k, preferred_element_type=jnp.float32) * ATTN_SCALE
    decay = jnp.transpose(c_q, (0, 2, 1))[..., :, None] - jnp.transpose(c_k, (0, 2, 1))[..., None, :]
    s = jnp.where(k_pos[None, :] <= q_pos[:, None], s + decay, NEG)
    p = jax.nn.softmax(s, axis=-1)
    return jnp.einsum('bhqk,bkhd->bqhd', p.astype(v.dtype), v)


def mixer_layer(x, norm_g, w_in, b_f, q_g, k_g, conv_w, att_g, conv_g, w_out,
                past_k=None, past_v=None, past_logf=None, past_conv=None):
    b, n, _ = x.shape
    h = rmsnorm(x, norm_g)
    proj = h @ w_in
    q, k, v, g_a, f_pre, cb, cc, ch, g_c = jnp.split(proj, SPLIT_POINTS, axis=-1)
    q = rmsnorm(q.reshape(b, n, N_HEADS, HEAD_DIM), q_g)
    k = rmsnorm(k.reshape(b, n, N_HEADS, HEAD_DIM), k_g)
    v = v.reshape(b, n, N_HEADS, HEAD_DIM)
    logf = jax.nn.log_sigmoid((f_pre + b_f).astype(jnp.float32))

    if past_k is None:
        c = jnp.cumsum(logf, axis=1)
        outs = []
        for i in range(n // Q_BLOCK):
            s0, e = i * Q_BLOCK, (i + 1) * Q_BLOCK
            outs.append(fox_attention(q[:, s0:e], k[:, :e], v[:, :e], c[:, s0:e], c[:, :e],
                                      jnp.arange(s0, e), jnp.arange(e)))
        att = jnp.concatenate(outs, axis=1)
        conv_past = jnp.zeros((b, CONV_W - 1, CONV_DIM), x.dtype)
    else:
        p_len = past_k.shape[1]
        k_all = jnp.concatenate([past_k.astype(k.dtype), k], axis=1)
        v_all = jnp.concatenate([past_v.astype(v.dtype), v], axis=1)
        c = jnp.cumsum(jnp.concatenate([past_logf.astype(jnp.float32), logf], axis=1), axis=1)
        att = fox_attention(q, k_all, v_all, c[:, p_len:], c,
                            p_len + jnp.arange(n), jnp.arange(p_len + n))
        conv_past = past_conv.astype(x.dtype)

    u = cc * ch
    u_pad = jnp.concatenate([conv_past, u], axis=1)
    y = sum(conv_w[i] * u_pad[:, i:i + n] for i in range(CONV_W))
    z = cb * y

    att = att.reshape(b, n, ATT_DIM)
    mix = jnp.concatenate([rmsnorm(att, att_g) * jax.nn.silu(g_a),
                           rmsnorm(z, conv_g) * jax.nn.silu(g_c)], axis=-1)
    out = x + mix @ w_out
    return out, k, v, logf.astype(x.dtype), u_pad[:, -(CONV_W - 1):]


def setup_inputs(seed: int = 0) -> dict:
    key = jax.random.key(seed)
    ks = jax.random.split(key, 16)
    f32 = jnp.float32
    x_prompt = jax.random.normal(ks[0], (BATCH, SEQ, D_MODEL), f32)
    x_sample = jax.random.normal(ks[1], (DEC_BATCH, DEC_SEQ, D_MODEL), f32)
    cache_k = jax.random.normal(ks[2], (DEPTH, DEC_BATCH, PAST_LEN, N_HEADS, HEAD_DIM), f32)
    cache_v = jax.random.normal(ks[3], (DEPTH, DEC_BATCH, PAST_LEN, N_HEADS, HEAD_DIM), f32)
    cache_logf = jax.nn.log_sigmoid(3.0 + jax.random.normal(ks[4], (DEPTH, DEC_BATCH, PAST_LEN, N_HEADS), f32))
    state_conv = 0.5 * jax.random.normal(ks[5], (DEPTH, DEC_BATCH, CONV_W - 1, CONV_DIM), f32)
    norm_g = 1.0 + 0.01 * jax.random.normal(ks[6], (DEPTH, D_MODEL), f32)
    w_in = jax.random.normal(ks[7], (DEPTH, D_MODEL, IN_DIM), f32) * D_MODEL ** -0.5
    b_f = jax.random.uniform(ks[8], (DEPTH, N_HEADS), f32, minval=1.0, maxval=6.0)
    q_norm_g = 1.0 + 0.01 * jax.random.normal(ks[9], (DEPTH, HEAD_DIM), f32)
    k_norm_g = 1.0 + 0.01 * jax.random.normal(ks[10], (DEPTH, HEAD_DIM), f32)
    conv_w = jax.random.normal(ks[11], (DEPTH, CONV_W, CONV_DIM), f32) * CONV_W ** -0.5
    att_out_g = 1.0 + 0.01 * jax.random.normal(ks[12], (DEPTH, ATT_DIM), f32)
    conv_out_g = 1.0 + 0.01 * jax.random.normal(ks[13], (DEPTH, CONV_DIM), f32)
    w_out = jax.random.normal(ks[14], (DEPTH, MIX_DIM, D_MODEL), f32) * (0.5 * MIX_DIM ** -0.5)
    return {"x_prompt": x_prompt, "x_sample": x_sample, "cache_k": cache_k, "cache_v": cache_v,
            "cache_logf": cache_logf, "state_conv": state_conv, "norm_g": norm_g, "w_in": w_in,
            "b_f": b_f, "q_norm_g": q_norm_g, "k_norm_g": k_norm_g, "conv_w": conv_w,
            "att_out_g": att_out_g, "conv_out_g": conv_out_g, "w_out": w_out}


def reference(x_prompt, x_sample, cache_k, cache_v, cache_logf, state_conv, norm_g, w_in, b_f,
              q_norm_g, k_norm_g, conv_w, att_out_g, conv_out_g, w_out):
    yp, ys = x_prompt, x_sample
    kp, vp, fp, cp, ksm, vsm, fsm, csm = [], [], [], [], [], [], [], []
    for l in range(DEPTH):
        params = (norm_g[l], w_in[l], b_f[l], q_norm_g[l], k_norm_g[l], conv_w[l],
                  att_out_g[l], conv_out_g[l], w_out[l])
        yp, k1, v1, f1, c1 = mixer_layer(yp, *params)
        ys, k2, v2, f2, c2 = mixer_layer(ys, *params, cache_k[l], cache_v[l], cache_logf[l], state_conv[l])
        kp.append(k1); vp.append(v1); fp.append(f1); cp.append(c1)
        ksm.append(k2); vsm.append(v2); fsm.append(f2); csm.append(c2)
    return (yp, ys, jnp.stack(kp), jnp.stack(vp), jnp.stack(fp), jnp.stack(cp),
            jnp.stack(ksm), jnp.stack(vsm), jnp.stack(fsm), jnp.stack(csm))
```

```cpp
#include <hip/hip_runtime.h>
#include <hip/hip_cooperative_groups.h>
#include <cstdio>
#include <cstdint>

constexpr int DM = 1024, NB = 32, SEQ = 2048, DEPTH = 2, DB = 16, DSEQ = 64, PAST = 2048, NH = 8, HD = 64;
constexpr int ATT = 512, CONV = 512, IN_DIM = 4104;
constexpr int NPR = NB * SEQ, NSR = DB * DSEQ, NROW = NPR + NSR;
constexpr float EPS = 1e-6f;
constexpr float LOG2E = 1.4426950408889634f;
constexpr float C2 = 0.125f * LOG2E;
constexpr int CQ = 0, CK = 512, CV = 1024, CGA = 1536, CF = 2048, CB = 2056, CC = 2568, CH = 3080, CGC = 3592;
constexpr size_t OFF_Y = 0, OFF_YS = 67108864, OFF_KP = 68157440, OFF_VP = 135266304, OFF_LP = 202375168, OFF_CP = 203423744,
                 OFF_KS = 203489280, OFF_VS = 204537856, OFF_LS = 205586432, OFF_CS = 205602816, OUT_TOTAL = 205635584;
constexpr size_t MiB = 1u << 20;
constexpr size_t WS_CTL = 0;
constexpr size_t WS_WINT = 1 * MiB;
constexpr size_t WS_WF = 17 * MiB;
constexpr size_t WS_WOUTT = 18 * MiB;
constexpr size_t WS_XB = 22 * MiB;
constexpr size_t WS_RSTD = 152 * MiB;
constexpr size_t WS_Q = 153 * MiB;
constexpr size_t WS_KB = 218 * MiB;
constexpr size_t WS_VB = 283 * MiB;
constexpr size_t WS_GA = 348 * MiB;
constexpr size_t WS_MIX = 413 * MiB;
constexpr size_t WS_ASS = 543 * MiB;
constexpr size_t WS_CSS = 546 * MiB;
constexpr size_t WS_HALO = 555 * MiB;
constexpr size_t WS_NBP = 706 * MiB;
constexpr size_t WS_NBS = 708 * MiB;
constexpr size_t WS_RC = 710 * MiB;
constexpr size_t WS_T0 = 711 * MiB;
constexpr size_t WS_END = 712 * MiB;

typedef unsigned short bf16_t;
__device__ __forceinline__ unsigned f2bf(float f) { unsigned u = __builtin_bit_cast(unsigned, f); return (u + 0x7fffu + ((u >> 16) & 1u)) >> 16; }
__device__ __forceinline__ float bf2f(unsigned h) { return __builtin_bit_cast(float, h << 16); }

struct Ptrs {
    const float *x_prompt, *x_sample, *cache_k, *cache_v, *cache_logf, *state_conv, *norm_g, *w_in, *b_f, *q_g, *k_g, *conv_w, *att_g, *conv_g, *w_out;
    float* out; unsigned char* ws;
};


#define LAS __attribute__((address_space(3)))
#define GAS __attribute__((address_space(1)))
typedef short bf16x8 __attribute__((ext_vector_type(8)));
typedef float f32x4 __attribute__((ext_vector_type(4)));
typedef float f32x2 __attribute__((ext_vector_type(2)));
typedef unsigned u32x4 __attribute__((ext_vector_type(4)));
typedef unsigned u32x2 __attribute__((ext_vector_type(2)));
constexpr int NWAVES = 8;
constexpr int RING_BYTES = 131072, TAB_OFF = 131072, T0_OFF = 147456, BST_OFF = 151296, LDS_BYTES = 151552;
constexpr int NBLK64 = NROW / 64;
constexpr size_t HALO_STRIDE = (size_t)NBLK64 * 2 * CONV;

__device__ __forceinline__ unsigned cvt_pk_bf16(float lo, float hi) { unsigned r; asm volatile("v_cvt_pk_bf16_f32 %0, %1, %2" : "=v"(r) : "v"(lo), "v"(hi)); return r; }
__device__ __forceinline__ float logsig_fast(float x) {
    const float e = __builtin_amdgcn_exp2f(-fabsf(x) * LOG2E);
    const float l1p = e < 0.00390625f ? e * (1.f - e * (0.5f - e * 0.33333334f)) : __builtin_amdgcn_logf(1.f + e) * 0.6931471805599453f;
    return fminf(x, 0.f) - l1p;
}
__device__ __forceinline__ float fast_silu(float x) { return x * __builtin_amdgcn_rcpf(1.f + __builtin_amdgcn_exp2f(-x * LOG2E)); }

namespace pg8 {
constexpr int BM = 256, BK = 64, HALF = 128, HTB = HALF * BK * 2, STAGE_BYTES = 8 * HTB, NXCD = 8, WGM = 8;
__host__ __device__ __forceinline__ int lds_byte(int r, int c) { const int st = (r >> 4) * 2 + (c >> 5), rr = r & 15, cc = c & 31, ob = rr * 64 + cc * 2; return st * 1024 + (ob ^ (((ob >> 9) & 1) << 5)); }
__host__ __device__ __forceinline__ void stage_rc(int b, int& R, int& C) { const int st = b / 1024, sb = b % 1024, swz = sb ^ (((sb >> 9) & 1) << 5); R = (st >> 1) * 16 + swz / 64; C = (st & 1) * 32 + (swz % 64) / 2; }
struct Unit { int pm, pn; };
struct Gemm { const bf16_t* A; const bf16_t* Bt; int M, N, K; };
struct StaticOrder {
    int nM, nN, nwg, G, c;
    __host__ __device__ void init(int M, int N, int G_, int c_) { nM = M / BM; nN = N / BM; nwg = nM * nN; G = G_; c = c_; }
    __host__ __device__ bool next(int i, Unit& u) const {
        const long L = (long)i * G + c; if (L >= nwg) return false;
        int wgid = (int)L; { const int q = nwg / NXCD, r = nwg % NXCD, xcd = wgid % NXCD, off = wgid / NXCD; wgid = (xcd < r ? xcd * (q + 1) : r * (q + 1) + (xcd - r) * q) + off; }
        const int nig = WGM * nN, gid = wgid / nig, fm = gid * WGM, gsz = (nM - fm) < WGM ? (nM - fm) : WGM;
        u.pm = fm + ((wgid % nig) % gsz); u.pn = (wgid % nig) / gsz; return true;
    }
};
template <class Epi, class Sched, bool ALIGN_EPI, bool SP2>
__device__ __forceinline__ void gemm_phase(LAS unsigned char* lds, const Gemm g, const Sched& S, const Epi& E, const int tid) {
    const int wid = __builtin_amdgcn_readfirstlane(tid >> 6), lane = tid & 63, wr = wid >> 2, wc = wid & 3, fr = lane & 15, fq = lane >> 4;
    const int K = g.K, nt = K / BK;
    unsigned voffA[2], voffB[2];
#pragma unroll
    for (int i = 0; i < 2; ++i) { int R, C; stage_rc(tid * 16 + i * 8192, R, C); voffA[i] = (unsigned)(R * K + C) * 2u; voffB[i] = (unsigned)(R * K + C) * 2u; }
    const size_t kstep = (size_t)(BK * 2);
    const size_t hstep = (size_t)HALF * K * 2;
    const size_t tstep = 2 * hstep;
    const unsigned ldsw = (unsigned)wid * 1024u;
    const int aoff = lds_byte(wr * 64 + fr, fq * 8), boff = lds_byte(wc * 32 + fr, fq * 8);
#define PG8_SA(b, h) (((b) * 2 + (h)) * HTB)
#define PG8_SB(b, h) ((4 + (b) * 2 + (h)) * HTB)
#define PG8_STAGE(bufoff, gbase, voff) do { _Pragma("unroll") for (int _i = 0; _i < 2; ++_i) \
        __builtin_amdgcn_global_load_lds((const unsigned*)((const char*)(gbase) + (voff)[_i]), (LAS unsigned*)(lds + (bufoff) + ldsw + _i * 8192), 16, 0, 0); } while (0)
#define PG8_LDA(dst, b, h) do { _Pragma("unroll") for (int m = 0; m < 4; ++m) _Pragma("unroll") for (int k = 0; k < 2; ++k) dst[m][k] = *(const LAS bf16x8*)(lds + PG8_SA(b, h) + aoff + m * 2048 + k * 1024); } while (0)
#define PG8_LDB(dst, b, h) do { _Pragma("unroll") for (int n = 0; n < 2; ++n) _Pragma("unroll") for (int k = 0; k < 2; ++k) dst[n][k] = *(const LAS bf16x8*)(lds + PG8_SB(b, h) + boff + n * 2048 + k * 1024); } while (0)
#define PG8_MMA(ai, bj, At, Bt) do { __builtin_amdgcn_s_setprio(1); _Pragma("unroll") for (int m = 0; m < 4; ++m) _Pragma("unroll") for (int n = 0; n < 2; ++n) _Pragma("unroll") for (int k = 0; k < 2; ++k) \
        acc[ai][bj][m][n] = __builtin_amdgcn_mfma_f32_16x16x32_bf16(Bt[n][k], At[m][k], acc[ai][bj][m][n], 0, 0, 0); __builtin_amdgcn_s_setprio(0); } while (0)
#define PG8_WAIT_V(n) asm volatile("s_waitcnt vmcnt(" #n ")" ::: "memory")
#define PG8_WAIT_L(n) asm volatile("s_waitcnt lgkmcnt(" #n ")" ::: "memory")
#define PG8_BAR __builtin_amdgcn_s_barrier()
#define PG8_SCHED __builtin_amdgcn_sched_barrier(0)
    Unit cur, nxt; int ui = 0;
    if (!S.next(0, cur)) return;
    f32x4 acc[2][2][4][2];
#pragma unroll
    for (int a = 0; a < 2; ++a)
#pragma unroll
        for (int b = 0; b < 2; ++b)
#pragma unroll
            for (int m = 0; m < 4; ++m)
#pragma unroll
                for (int n = 0; n < 2; ++n) acc[a][b][m][n] = (f32x4){0.f, 0.f, 0.f, 0.f};
    bf16x8 At[4][2], B0[2][2], B1[2][2];
    const char* cA = (const char*)g.A + (size_t)cur.pm * tstep; const char* cB = (const char*)g.Bt + (size_t)cur.pn * tstep;
    typename Epi::PrepRegs pr;
    if constexpr (Epi::PREP) { E.prep_load(cur, tid, pr); E.prep_store(0, tid, pr); asm volatile("" ::: "memory"); }
    if constexpr (SP2) {
        PG8_STAGE(PG8_SB(0, 0), cB, voffB); PG8_STAGE(PG8_SB(0, 1), cB + hstep, voffB); PG8_STAGE(PG8_SA(0, 0), cA, voffA); PG8_STAGE(PG8_SA(0, 1), cA + hstep, voffA);
        if (wr == 1) PG8_BAR;
        PG8_WAIT_V(2); PG8_BAR;
        PG8_STAGE(PG8_SB(1, 0), cB + kstep, voffB); PG8_STAGE(PG8_SA(1, 0), cA + kstep, voffA); PG8_STAGE(PG8_SB(1, 1), cB + hstep + kstep, voffB);
        PG8_WAIT_V(6); PG8_BAR;
    } else {
        PG8_STAGE(PG8_SB(0, 0), cB, voffB); PG8_STAGE(PG8_SA(0, 0), cA, voffA); PG8_STAGE(PG8_SB(0, 1), cB + hstep, voffB); PG8_STAGE(PG8_SA(0, 1), cA + hstep, voffA);
        if (wr == 1) PG8_BAR;
        PG8_WAIT_V(4); PG8_BAR;
        PG8_STAGE(PG8_SB(1, 0), cB + kstep, voffB); PG8_STAGE(PG8_SA(1, 0), cA + kstep, voffA); PG8_STAGE(PG8_SB(1, 1), cB + hstep + kstep, voffB);
        PG8_WAIT_V(6); PG8_BAR;
    }
    for (;;) {
        const bool has_next = S.next(ui + 1, nxt);
        const char* nA = has_next ? (const char*)g.A + (size_t)nxt.pm * tstep : cA; const char* nB = has_next ? (const char*)g.Bt + (size_t)nxt.pn * tstep : cB;
        for (int t = 0; t < nt; t += 2) {
            const bool last = (t == nt - 2);
            const char* a1 = cA + (size_t)(t + 1) * kstep;
            const char* a2 = last ? nA : cA + (size_t)(t + 2) * kstep; const char* b2 = last ? nB : cB + (size_t)(t + 2) * kstep;
            const char* a3 = a2 + kstep; const char* b3 = b2 + kstep;
            if constexpr (SP2) {
            PG8_LDB(B0, 0, 0); PG8_LDB(B1, 0, 1); PG8_SCHED; PG8_LDA(At, 0, 0); PG8_STAGE(PG8_SA(1, 1), a1 + hstep, voffA);
            PG8_WAIT_V(8); PG8_WAIT_L(0); PG8_BAR; PG8_MMA(0, 0, At, B0); PG8_MMA(0, 1, At, B1); PG8_BAR; PG8_SCHED;
            PG8_LDA(At, 0, 1); PG8_STAGE(PG8_SB(0, 0), b2, voffB); PG8_STAGE(PG8_SB(0, 1), b2 + hstep, voffB); PG8_STAGE(PG8_SA(0, 0), a2, voffA);
            PG8_WAIT_V(8); PG8_WAIT_L(0); PG8_BAR; PG8_MMA(1, 0, At, B0); PG8_MMA(1, 1, At, B1); PG8_BAR; PG8_SCHED;
            PG8_LDB(B0, 1, 0); PG8_LDB(B1, 1, 1); PG8_SCHED; PG8_LDA(At, 1, 0); PG8_STAGE(PG8_SA(0, 1), a2 + hstep, voffA);
            PG8_WAIT_V(8); PG8_WAIT_L(0); PG8_BAR; PG8_MMA(0, 0, At, B0); PG8_MMA(0, 1, At, B1); PG8_BAR; PG8_SCHED;
            PG8_LDA(At, 1, 1); PG8_STAGE(PG8_SB(1, 0), b3, voffB); PG8_STAGE(PG8_SB(1, 1), b3 + hstep, voffB); PG8_STAGE(PG8_SA(1, 0), a3, voffA);
            PG8_WAIT_V(8); PG8_WAIT_L(0); PG8_BAR; PG8_MMA(1, 0, At, B0); PG8_MMA(1, 1, At, B1); PG8_BAR; PG8_SCHED;
            } else {
            PG8_LDB(B0, 0, 0); PG8_SCHED; PG8_LDA(At, 0, 0); PG8_STAGE(PG8_SA(1, 1), a1 + hstep, voffA);
            PG8_WAIT_L(8); PG8_BAR; PG8_WAIT_L(0); PG8_MMA(0, 0, At, B0); PG8_BAR; PG8_SCHED;
            PG8_LDB(B1, 0, 1); PG8_STAGE(PG8_SB(0, 0), b2, voffB);
            PG8_BAR; PG8_WAIT_L(0); PG8_MMA(0, 1, At, B1); PG8_BAR;
            PG8_LDA(At, 0, 1); PG8_STAGE(PG8_SA(0, 0), a2, voffA);
            PG8_BAR; PG8_WAIT_L(0); PG8_MMA(1, 0, At, B0); PG8_BAR; PG8_SCHED;
            PG8_STAGE(PG8_SB(0, 1), b2 + hstep, voffB);
            PG8_WAIT_V(6); PG8_BAR; PG8_MMA(1, 1, At, B1); PG8_BAR;
            PG8_LDB(B0, 1, 0); PG8_SCHED; PG8_LDA(At, 1, 0); PG8_STAGE(PG8_SA(0, 1), a2 + hstep, voffA);
            PG8_WAIT_L(8); PG8_BAR; PG8_WAIT_L(0); PG8_MMA(0, 0, At, B0); PG8_BAR; PG8_SCHED;
            PG8_LDB(B1, 1, 1); PG8_STAGE(PG8_SB(1, 0), b3, voffB);
            PG8_BAR; PG8_WAIT_L(0); PG8_MMA(0, 1, At, B1); PG8_BAR;
            PG8_LDA(At, 1, 1); PG8_STAGE(PG8_SA(1, 0), a3, voffA);
            PG8_BAR; PG8_WAIT_L(0); PG8_MMA(1, 0, At, B0); PG8_BAR; PG8_SCHED;
            PG8_STAGE(PG8_SB(1, 1), b3 + hstep, voffB);
            PG8_WAIT_V(6); PG8_BAR; PG8_MMA(1, 1, At, B1); PG8_BAR;
            }
            if constexpr (Epi::MID) { if (t == nt / 2 - 2) E.mid(acc, ui & 1, wr, fr); }
        }
        if constexpr (ALIGN_EPI) { if (wr == 0) PG8_BAR; }
        if constexpr (Epi::PREP) { if (has_next) E.prep_load(nxt, tid, pr); }
        E(acc, cur, wr, wc, fr, fq, ui & 1);
        if constexpr (Epi::PREP) { if (has_next) { E.prep_store((ui + 1) & 1, tid, pr); asm volatile("" ::: "memory"); } }
        if (!has_next) break;
#pragma unroll
        for (int a = 0; a < 2; ++a)
#pragma unroll
            for (int b = 0; b < 2; ++b)
#pragma unroll
                for (int m = 0; m < 4; ++m)
#pragma unroll
                    for (int n = 0; n < 2; ++n) acc[a][b][m][n] = (f32x4){0.f, 0.f, 0.f, 0.f};
        cur = nxt; cA = nA; cB = nB; ++ui;
        if constexpr (ALIGN_EPI) { if (wr == 1) PG8_BAR; }
    }
    PG8_WAIT_V(0);
    if constexpr (!ALIGN_EPI) { if (wr == 0) PG8_BAR; }
    PG8_BAR;
#undef PG8_SA
#undef PG8_SB
#undef PG8_STAGE
#undef PG8_LDA
#undef PG8_LDB
#undef PG8_MMA
#undef PG8_WAIT_V
#undef PG8_WAIT_L
#undef PG8_BAR
#undef PG8_SCHED
}
}

__device__ __forceinline__ float rows4_sum(float x) {
    auto a = __builtin_amdgcn_permlane16_swap(__float_as_uint(x), __float_as_uint(x), false, false); const float y = __uint_as_float(a[0]) + __uint_as_float(a[1]);
    auto b = __builtin_amdgcn_permlane32_swap(__float_as_uint(y), __float_as_uint(y), false, false); return __uint_as_float(b[0]) + __uint_as_float(b[1]);
}
struct EpiA {
    static constexpr bool MID = false, PREP = true; struct PrepRegs { float rs; };
    const Ptrs& P; int l; LAS float* tab; const LAS float* gl;
    __device__ __forceinline__ void prep_load(const pg8::Unit& u, int tid, PrepRegs& r) const { if (tid < 256) r.rs = ((const float*)(P.ws + WS_RSTD))[u.pm * 256 + tid]; }
    __device__ __forceinline__ void prep_store(int buf, int tid, const PrepRegs& r) const { if (tid < 256) tab[buf * 256 + tid] = r.rs; }
    template <int KIND>
    __device__ __forceinline__ void attn_tile(const f32x4 (&acc)[2][2][4][2], const pg8::Unit& u, int wr, int wc, int fr, int fq, int buf) const {
        const bool smp = u.pm >= NPR / 256;
        const int head = 4 * (u.pn & 1) + wc, row0 = u.pm * 256 + wr * 64;
        const LAS float* rst = tab + buf * 256 + wr * 64 + fr;
        const unsigned vrow = (unsigned)(fr * (ATT * 2) + fq * 16);
        const unsigned vf32 = (unsigned)(fr * (ATT * 4) + fq * 16);
        const unsigned vimg = smp ? vrow : (KIND == 1 ? (unsigned)(fq * 1024 + fr * 16) : (unsigned)(fr * 64 + fq * 16));
        unsigned char* const rowmaj = P.ws + (KIND == 0 ? WS_Q : KIND == 1 ? WS_KB : KIND == 2 ? WS_VB : WS_GA) + ((size_t)row0 * ATT + head * 64) * 2;
        unsigned char* const img = P.ws + (KIND == 1 ? WS_KB : WS_VB) + ((size_t)((u.pm >> 3) * NH + head) * 32 + ((u.pm & 7) * 4 + wr)) * 8192;
        float* const of32 = (smp ? P.out + (KIND == 1 ? OFF_KS : OFF_VS) + ((size_t)l * NSR + (row0 - NPR)) * ATT : P.out + (KIND == 1 ? OFF_KP : OFF_VP) + ((size_t)l * NPR + row0) * ATT) + head * 64;
        f32x4 gg[2][2];
        if constexpr (KIND <= 1) { const LAS float* gsrc = gl + (KIND == 0 ? 0 : HD) + 8 * fq;
#pragma unroll
            for (int bj = 0; bj < 2; ++bj)
#pragma unroll
                for (int n = 0; n < 2; ++n) gg[bj][n] = *(const LAS f32x4*)(gsrc + 32 * bj + 4 * n); }
#pragma unroll
        for (int ai = 0; ai < 2; ++ai)
#pragma unroll
            for (int m = 0; m < 4; ++m) {
                const int rr = 128 * ai + 16 * m; const float rs = rst[rr];
                float sc = rs;
                if constexpr (KIND <= 1) {
                    float s0 = 0.f, s1 = 0.f;
#pragma unroll
                    for (int bj = 0; bj < 2; ++bj)
#pragma unroll
                        for (int j = 0; j < 4; ++j) { s0 = fmaf(acc[ai][bj][m][0][j], acc[ai][bj][m][0][j], s0); s1 = fmaf(acc[ai][bj][m][1][j], acc[ai][bj][m][1][j], s1); }
                    const float ss = rows4_sum(s0 + s1);
                    sc = rs * rsqrtf(ss * (rs * rs) * (1.f / HD) + EPS);
                }
#pragma unroll
                for (int bj = 0; bj < 2; ++bj) {
                    f32x4 a, b;
#pragma unroll
                    for (int j = 0; j < 4; ++j) {
                        if constexpr (KIND <= 1) { a[j] = acc[ai][bj][m][0][j] * sc * gg[bj][0][j]; b[j] = acc[ai][bj][m][1][j] * sc * gg[bj][1][j]; }
                        else if constexpr (KIND == 2) { a[j] = acc[ai][bj][m][0][j] * sc; b[j] = acc[ai][bj][m][1][j] * sc; }
                        else { a[j] = fast_silu(acc[ai][bj][m][0][j] * sc); b[j] = fast_silu(acc[ai][bj][m][1][j] * sc); } }
                    if constexpr (KIND == 1 || KIND == 2) if (smp) { float* o = of32 + (size_t)rr * ATT + 32 * bj;
                        f32x4 a2, b2;
#pragma unroll
                        for (int j = 0; j < 4; ++j) {
                            auto s1 = __builtin_amdgcn_permlane16_swap(__float_as_uint(a[j]), __float_as_uint(b[j]), false, false);
                            auto s2 = __builtin_amdgcn_permlane32_swap(s1[0], s1[1], false, false);
                            a2[j] = __uint_as_float(s2[0]); b2[j] = __uint_as_float(s2[1]); }
                        __builtin_nontemporal_store(a2, (f32x4*)((unsigned char*)o + vf32)); __builtin_nontemporal_store(b2, (f32x4*)((unsigned char*)o + 64 + vf32)); }
                    u32x4 w; w.x = cvt_pk_bf16(a[0], a[1]); w.y = cvt_pk_bf16(a[2], a[3]); w.z = cvt_pk_bf16(b[0], b[1]); w.w = cvt_pk_bf16(b[2], b[3]);
                    if constexpr (KIND == 0 || KIND == 3) *(u32x4*)(rowmaj + (size_t)rr * (ATT * 2) + 64 * bj + vrow) = w;
                    else { unsigned char* d = smp ? rowmaj + (size_t)rr * (ATT * 2) + 64 * bj
                                                  : img + (size_t)(2 * ai) * 8192 + bj * 4096 + m * (KIND == 1 ? 256 : 1024);
                        *(u32x4*)(d + vimg) = w; }
                }
            }
    }
    __device__ __forceinline__ void operator()(const f32x4 (&acc)[2][2][4][2], const pg8::Unit& u, int wr, int wc, int fr, int fq, int buf) const {
        const int lane = fq * 16 + fr;
        const LAS float* rstd = tab + buf * 256 - u.pm * 256;
        const int rbase = u.pm * 256 + wr * 64 + fr;
        const bool smp = u.pm >= NPR / 256;
        if (u.pn < 8) {
            const int kp = u.pn >> 1;
            if (kp == 0) attn_tile<0>(acc, u, wr, wc, fr, fq, buf); else if (kp == 1) attn_tile<1>(acc, u, wr, wc, fr, fq, buf);
            else if (kp == 2) attn_tile<3>(acc, u, wr, wc, fr, fq, buf); else attn_tile<2>(acc, u, wr, wc, fr, fq, buf);
        } else {
            const int g = u.pn - 8, ch0 = 64 * g + 16 * wc + 4 * fq;
            const LAS float* cw = gl + 2 * HD + ch0;
            const f32x4 w0 = *(const LAS f32x4*)cw, w1 = *(const LAS f32x4*)(cw + CONV), w2 = *(const LAS f32x4*)(cw + 2 * CONV);
            float* halo = (float*)(P.ws + WS_HALO);
            const int row0 = u.pm * 256 + wr * 64;
            const LAS float* rst = tab + buf * 256 + wr * 64 + fr;
            unsigned char* const mixb = P.ws + WS_MIX + ((size_t)row0 * DM + 512 + 64 * g + 16 * wc) * 2;
            float* const cssb = (float*)(P.ws + WS_CSS) + (size_t)row0 * 32 + 4 * g + wc;
            const unsigned vmix = (unsigned)(fr * (DM * 2) + fq * 8), vcss = (unsigned)(fr * 128);
#pragma unroll
            for (int ai = 0; ai < 2; ++ai) {
                const int kb = 4 * u.pm + 2 * ai + wr;
                f32x4 p1 = (f32x4){0.f, 0.f, 0.f, 0.f}, p2 = p1; float zsv[4];
#pragma unroll
                for (int m = 0; m < 4; ++m) {
                    const int rr = 128 * ai + 16 * m; const float rs = rst[rr];
                    f32x4 Bv, uu, Gv, r1, r2, sg;
#pragma unroll
                    for (int j = 0; j < 4; ++j) { Bv[j] = acc[ai][0][m][0][j] * rs; uu[j] = (acc[ai][0][m][1][j] * rs) * (acc[ai][1][m][0][j] * rs); Gv[j] = acc[ai][1][m][1][j] * rs; }
#pragma unroll
                    for (int j = 0; j < 4; ++j) {
                        asm("s_nop 1\n\tv_mov_b32_dpp %0, %2 row_ror:1 row_mask:0xf bank_mask:0xf\n\tv_mov_b32_dpp %1, %2 row_ror:2 row_mask:0xf bank_mask:0xf" : "=&v"(r1[j]), "=&v"(r2[j]) : "v"(uu[j]));
                        sg[j] = fast_silu(Gv[j]); }
                    f32x4 z; float zs = 0.f;
#pragma unroll
                    for (int j = 0; j < 4; ++j) { const float um1 = fr >= 1 ? r1[j] : p1[j], um2 = fr >= 2 ? r2[j] : p2[j];
                        z[j] = Bv[j] * fmaf(w0[j], um2, fmaf(w1[j], um1, w2[j] * uu[j])); zs = fmaf(z[j], z[j], zs); }
                    zsv[m] = zs;
                    const bool skip = (m == 0) && (fr < 2);
                    if (!skip) { u32x2 w; w.x = cvt_pk_bf16(z[0] * sg[0], z[1] * sg[1]); w.y = cvt_pk_bf16(z[2] * sg[2], z[3] * sg[3]);
                        *(u32x2*)(mixb + (size_t)rr * (DM * 2) + vmix) = w; }
                    else { float* hp = halo + ((size_t)kb * 2 + fr) * CONV + ch0;
                        *(f32x4*)(hp + HALO_STRIDE) = Bv; *(f32x4*)(hp + 2 * HALO_STRIDE) = uu; *(f32x4*)(hp + 3 * HALO_STRIDE) = sg; }
                    if (m == 3 && fr >= 14) {
                        *(f32x4*)(halo + ((size_t)kb * 2 + (fr - 14)) * CONV + ch0) = uu;
                        if (smp) *(f32x4*)(P.out + OFF_CS + (((size_t)l * DB + (kb - NPR / 64)) * 2 + (fr - 14)) * CONV + ch0) = uu;
                        else if ((kb & 31) == 31) *(f32x4*)(P.out + OFF_CP + (((size_t)l * NB + (kb >> 5)) * 2 + (fr - 14)) * CONV + ch0) = uu;
                    }
                    p1 = r1; p2 = r2;
                }
#pragma unroll
                for (int m = 0; m < 4; ++m) zsv[m] = rows4_sum(zsv[m]);
#pragma unroll
                for (int m = 0; m < 4; ++m) if (fq == 0 && !(m == 0 && fr < 2)) *(float*)((unsigned char*)(cssb + (size_t)(128 * ai + 16 * m) * 32) + vcss) = zsv[m];
            }
        }
    }
};

struct EpiC {
    static constexpr bool MID = true, PREP = true;
    const Ptrs& P; int l; LAS f32x2* tab;
    struct PrepRegs { f32x4 a0, a1; float rc; };
    __device__ __forceinline__ void prep_load(const pg8::Unit& u, int tid, PrepRegs& r) const {
        if (tid < 256) { const int row = u.pm * 256 + tid; const f32x4* a = (const f32x4*)((const float*)(P.ws + WS_ASS) + (size_t)row * 8);
            r.a0 = a[0]; r.a1 = a[1]; r.rc = ((const float*)(P.ws + WS_RC))[row]; }
    }
    __device__ __forceinline__ void prep_store(int buf, int tid, const PrepRegs& r) const {
        if (tid < 256) { const f32x4 sa = r.a0 + r.a1; const float ra = rsqrtf(((sa[0] + sa[1]) + (sa[2] + sa[3])) * (1.f / ATT) + EPS);
            tab[buf * 256 + tid] = (f32x2){ra / r.rc, r.rc}; }
    }
    __device__ __forceinline__ void mid(f32x4 (&acc)[2][2][4][2], int buf, int wr, int fr) const {
        const unsigned a = (unsigned)(size_t)(tab + buf * 256 + wr * 64 + fr);
        float q0, q1, q2, q3, q4, q5, q6, q7;
        asm volatile("ds_read_b32 %0, %8\n\tds_read_b32 %1, %8 offset:128\n\tds_read_b32 %2, %8 offset:256\n\tds_read_b32 %3, %8 offset:384\n\t"
                     "ds_read_b32 %4, %8 offset:1024\n\tds_read_b32 %5, %8 offset:1152\n\tds_read_b32 %6, %8 offset:1280\n\tds_read_b32 %7, %8 offset:1408\n\ts_waitcnt lgkmcnt(0)"
                     : "=&v"(q0), "=&v"(q1), "=&v"(q2), "=&v"(q3), "=&v"(q4), "=&v"(q5), "=&v"(q6), "=&v"(q7) : "v"(a) : "memory");
        const float q[2][4] = {{q0, q1, q2, q3}, {q4, q5, q6, q7}};
#pragma unroll
        for (int ai = 0; ai < 2; ++ai)
#pragma unroll
            for (int m = 0; m < 4; ++m)
#pragma unroll
                for (int bj = 0; bj < 2; ++bj)
#pragma unroll
                    for (int n = 0; n < 2; ++n) acc[ai][bj][m][n] *= q[ai][m];
    }
    __device__ __forceinline__ void operator()(const f32x4 (&acc)[2][2][4][2], const pg8::Unit& u, int wr, int wc, int fr, int fq, int buf) const {
        const bool smp = u.pm >= NPR / 256; const int col0 = u.pn * 256 + wc * 32 + 8 * fq;
        bf16_t* xb = (bf16_t*)(P.ws + WS_XB);
        float* obase = (smp ? P.out + OFF_YS : P.out + OFF_Y);
        const int r0 = u.pm * 256 + wr * 64 + fr;
#pragma unroll
        for (int ai = 0; ai < 2; ++ai) {
            u32x4 x[4][2];
#pragma unroll
            for (int m = 0; m < 4; ++m) { const int r = r0 + ai * 128 + m * 16;
#pragma unroll
                for (int bj = 0; bj < 2; ++bj) x[m][bj] = __builtin_nontemporal_load((const u32x4*)(xb + (size_t)r * DM + col0 + bj * 128)); }
#pragma unroll
            for (int m = 0; m < 4; ++m) { const int rl = ai * 128 + wr * 64 + m * 16 + fr, r = u.pm * 256 + rl; const float rc = tab[buf * 256 + rl].y;
                const size_t off = (smp ? (size_t)(r - NPR) : (size_t)r) * DM + col0;
#pragma unroll
                for (int bj = 0; bj < 2; ++bj) { const u32x4 t = x[m][bj];
                    const f32x4 o0 = (f32x4){bf2f(t.x & 0xffffu), bf2f(t.x >> 16), bf2f(t.y & 0xffffu), bf2f(t.y >> 16)} + acc[ai][bj][m][0] * rc;
                    const f32x4 o1 = (f32x4){bf2f(t.z & 0xffffu), bf2f(t.z >> 16), bf2f(t.w & 0xffffu), bf2f(t.w >> 16)} + acc[ai][bj][m][1] * rc;
                    if (l == 0) { u32x4 w; w.x = cvt_pk_bf16(o0[0], o0[1]); w.y = cvt_pk_bf16(o0[2], o0[3]); w.z = cvt_pk_bf16(o1[0], o1[1]); w.w = cvt_pk_bf16(o1[2], o1[3]);
                        *(u32x4*)(xb + (size_t)r * DM + col0 + bj * 128) = w; }
                    else { __builtin_nontemporal_store(o0, (f32x4*)(obase + off + bj * 128)); __builtin_nontemporal_store(o1, (f32x4*)(obase + off + bj * 128 + 4)); } } }
            asm volatile("" ::: "memory");
        }
    }
};

__device__ __forceinline__ int destrow(int s) {
    if (s < 2048) { const int seg = s >> 9, c = s & 511, h = c >> 6, d = c & 63, i2 = d & 31;
        const int sp = seg == 2 ? 3 : seg == 3 ? 2 : seg;
        return 256 * (2 * sp + (h >> 2)) + 128 * (d >> 5) + 32 * (h & 3) + 16 * ((i2 >> 2) & 1) + 4 * (i2 >> 3) + (i2 & 3); }
    const int c2 = s - CB, kind = c2 >> 9, ch = c2 & 511;
    return 256 * (8 + (ch >> 6)) + 128 * (kind >> 1) + 32 * ((ch >> 4) & 3) + 16 * (kind & 1) + 4 * ((ch >> 2) & 3) + (ch & 3);
}
template <bool WIN>
__device__ __forceinline__ void prep_item(const float* W, int ldw, int s0, int k0, const float* kscale, bf16_t* WT, LAS float* scr, int lane) {
    float wv[32];
#pragma unroll
    for (int i = 0; i < 32; ++i) { const int kk = 2 * i + (lane >> 5); wv[i] = W[(size_t)(k0 + kk) * ldw + s0 + (lane & 31)]; }
    const float ks0 = kscale[k0 + lane];
#pragma unroll
    for (int i = 0; i < 32; ++i) { const int kk = 2 * i + (lane >> 5); scr[kk * 33 + (lane & 31)] = wv[i] * __shfl(ks0, kk); }
    asm volatile("s_waitcnt lgkmcnt(0)" ::: "memory");
    const int c = lane & 7;
#pragma unroll
    for (int j = 0; j < 4; ++j) { const int n = (lane >> 3) + 8 * j; const LAS float* s = scr + (8 * c) * 33 + n;
        u32x4 o; o.x = cvt_pk_bf16(s[0 * 33], s[1 * 33]); o.y = cvt_pk_bf16(s[2 * 33], s[3 * 33]); o.z = cvt_pk_bf16(s[4 * 33], s[5 * 33]); o.w = cvt_pk_bf16(s[6 * 33], s[7 * 33]);
        const int cc = s0 + n, i2 = cc & 31;
        const int dr = WIN ? destrow(cc) : ((cc & ~31) + 16 * ((i2 >> 2) & 1) + 4 * (i2 >> 3) + (i2 & 3));
        *(u32x4*)(WT + (size_t)dr * DM + k0 + 8 * c) = o; }
    asm volatile("s_waitcnt lgkmcnt(0)" ::: "memory");
}
__device__ __forceinline__ void phase_prep(const Ptrs& P, LAS unsigned char* lds, int gw, int NGW, int lane, int wave) {
    LAS float* scr = (LAS float*)(lds + wave * 16384);
    constexpr int I_IN = 16 * 128, I_OUT = 16 * 32, NITEMS = 2 * (I_IN + I_OUT);
    for (int it = gw; it < NITEMS; it += NGW) {
        const int l = it / (I_IN + I_OUT); int r = it % (I_IN + I_OUT);
        if (r < I_IN) { const int kb = r / 128, sb = r % 128, s0 = sb < 64 ? 32 * sb : CB + 32 * (sb - 64);
            prep_item<true>(P.w_in + (size_t)l * DM * IN_DIM, IN_DIM, s0, 64 * kb, P.norm_g + l * DM, (bf16_t*)(P.ws + WS_WINT) + (size_t)l * 4096 * DM, scr, lane); }
        else { r -= I_IN; const int kb = r / 32, nb = r % 32; const int k0 = 64 * kb;
            const float* gain = k0 < 512 ? P.att_g + l * ATT : P.conv_g + l * CONV - 512;
            prep_item<false>(P.w_out + (size_t)l * DM * DM, DM, 32 * nb, k0, gain, (bf16_t*)(P.ws + WS_WOUTT) + (size_t)l * DM * DM, scr, lane); }
    }
    for (int i = gw * 64 + lane; i < 2 * 8 * DM; i += NGW * 64) { const int l = i / (8 * DM), h = (i / DM) & 7, k = i % DM;
        ((float*)(P.ws + WS_WF))[i] = P.w_in[((size_t)l * DM + k) * IN_DIM + CF + h] * P.norm_g[l * DM + k]; }
}

template <int L> struct XRaw { typedef f32x4 T; };
template <> struct XRaw<1> { typedef u32x2 T; };
template <int L>
__device__ __forceinline__ void phase_x(const Ptrs& P, int gw, int NGW, int lane) {
    constexpr int l = L; typedef typename XRaw<L>::T RT;
    const float* wf = (const float*)(P.ws + WS_WF) + (size_t)l * 8 * DM;
    f32x4 w[8][4];
    if constexpr (L == 0) {
#pragma unroll
        for (int j = 0; j < 4; ++j)
#pragma unroll
            for (int c = 0; c < 4; ++c) { const int k = 256 * j + 4 * lane + c; const float gk = P.norm_g[k];
                const f32x4 a = *(const f32x4*)(P.w_in + (size_t)k * IN_DIM + CF), b = *(const f32x4*)(P.w_in + (size_t)k * IN_DIM + CF + 4);
                w[0][j][c] = a[0] * gk; w[1][j][c] = a[1] * gk; w[2][j][c] = a[2] * gk; w[3][j][c] = a[3] * gk;
                w[4][j][c] = b[0] * gk; w[5][j][c] = b[1] * gk; w[6][j][c] = b[2] * gk; w[7][j][c] = b[3] * gk; }
    } else {
#pragma unroll
        for (int h = 0; h < 8; ++h)
#pragma unroll
            for (int j = 0; j < 4; ++j) w[h][j] = *(const f32x4*)(wf + h * DM + 256 * j + 4 * lane);
    }
    const float bfv = P.b_f[l * NH + (lane >> 3)];
    const bool b5 = (lane & 32) != 0, b4 = (lane & 16) != 0, b3 = (lane & 8) != 0;
#define XLOAD(dst, r0_) do { _Pragma("unroll") for (int rr = 0; rr < 2; ++rr) { int row = (r0_) + rr * NGW; if (row >= NROW) row = gw; \
        if constexpr (L == 0) { const float* xin = row < NPR ? P.x_prompt + (size_t)row * DM : P.x_sample + (size_t)(row - NPR) * DM; \
            _Pragma("unroll") for (int j = 0; j < 4; ++j) dst[rr][j] = *(const f32x4*)(xin + 256 * j + 4 * lane); } \
        else { const u32x2* xb = (const u32x2*)((const bf16_t*)(P.ws + WS_XB) + (size_t)row * DM); \
            _Pragma("unroll") for (int j = 0; j < 4; ++j) dst[rr][j] = xb[64 * j + lane]; } } } while (0)
    RT cur[2][4], nxt[2][4];
    XLOAD(cur, gw);
    for (int row0 = gw; row0 < NROW; row0 += 2 * NGW) {
        XLOAD(nxt, row0 + 2 * NGW);
        f32x4 v[2][4]; float ss[2]; f32x4 flo[2], fhi[2];
#pragma unroll
        for (int rr = 0; rr < 2; ++rr) {
#pragma unroll
            for (int j = 0; j < 4; ++j) { if constexpr (L == 0) v[rr][j] = cur[rr][j];
                else { const u32x2 t = cur[rr][j]; v[rr][j] = (f32x4){bf2f(t.x & 0xffffu), __builtin_bit_cast(float, t.x & 0xffff0000u), bf2f(t.y & 0xffffu), __builtin_bit_cast(float, t.y & 0xffff0000u)}; } }
            float s_ = 0.f;
#pragma unroll
            for (int j = 0; j < 4; ++j) s_ += (v[rr][j][0] * v[rr][j][0] + v[rr][j][1] * v[rr][j][1]) + (v[rr][j][2] * v[rr][j][2] + v[rr][j][3] * v[rr][j][3]);
            ss[rr] = s_;
#pragma unroll
            for (int h = 0; h < 8; ++h) { f32x4 a = v[rr][0] * w[h][0] + v[rr][1] * w[h][1] + v[rr][2] * w[h][2] + v[rr][3] * w[h][3]; const float d_ = (a[0] + a[1]) + (a[2] + a[3]);
                if (h < 4) flo[rr][h] = d_; else fhi[rr][h - 4] = d_; }
        }
        f32x4 g4[2]; f32x2 g2[2]; float fh[2];
#pragma unroll
        for (int rr = 0; rr < 2; ++rr) {
#pragma unroll
            for (int i = 0; i < 4; ++i) { auto p_ = __builtin_amdgcn_permlane32_swap(__float_as_uint(flo[rr][i]), __float_as_uint(fhi[rr][i]), false, false); g4[rr][i] = __uint_as_float(p_[0]) + __uint_as_float(p_[1]); }
            { auto p_ = __builtin_amdgcn_permlane32_swap(__float_as_uint(ss[rr]), __float_as_uint(ss[rr]), false, false); ss[rr] = __uint_as_float(p_[0]) + __uint_as_float(p_[1]); } }
#pragma unroll
        for (int rr = 0; rr < 2; ++rr) {
#pragma unroll
            for (int i = 0; i < 2; ++i) { auto p_ = __builtin_amdgcn_permlane16_swap(__float_as_uint(g4[rr][i]), __float_as_uint(g4[rr][2 + i]), false, false); g2[rr][i] = __uint_as_float(p_[0]) + __uint_as_float(p_[1]); }
            { auto p_ = __builtin_amdgcn_permlane16_swap(__float_as_uint(ss[rr]), __float_as_uint(ss[rr]), false, false); ss[rr] = __uint_as_float(p_[0]) + __uint_as_float(p_[1]); } }
#pragma unroll
        for (int rr = 0; rr < 2; ++rr) { const float x_ = g2[rr][0], y_ = g2[rr][1]; const float snd_ = b3 ? x_ : y_, kp_ = b3 ? y_ : x_; float r_, q_;
            asm("s_nop 1\n\tv_add_f32_dpp %0, %1, %2 row_ror:8 row_mask:0xf bank_mask:0xf" : "=&v"(r_) : "v"(snd_), "v"(kp_)); fh[rr] = r_;
            asm("s_nop 1\n\tv_add_f32_dpp %0, %1, %1 row_ror:8 row_mask:0xf bank_mask:0xf" : "=&v"(q_) : "v"(ss[rr])); ss[rr] = q_; }
#define XDPP(x, n) do { float r_; asm("s_nop 1\n\tv_add_f32_dpp %0, %1, %1 row_shl:" #n " row_mask:0xf bank_mask:0xf bound_ctrl:1" : "=&v"(r_) : "v"(x)); x = r_; } while (0)
#pragma unroll
        for (int rr = 0; rr < 2; ++rr) { XDPP(fh[rr], 4); XDPP(ss[rr], 4); }
#pragma unroll
        for (int rr = 0; rr < 2; ++rr) { XDPP(fh[rr], 2); XDPP(ss[rr], 2); }
#pragma unroll
        for (int rr = 0; rr < 2; ++rr) { XDPP(fh[rr], 1); XDPP(ss[rr], 1); }
#undef XDPP
#pragma unroll
        for (int rr = 0; rr < 2; ++rr) { const int row = row0 + rr * NGW; if (row >= NROW) break;
            const float rstd = rsqrtf(ss[rr] * (1.f / DM) + EPS);
            if constexpr (L == 0) { u32x2* xb = (u32x2*)((bf16_t*)(P.ws + WS_XB) + (size_t)row * DM);
#pragma unroll
                for (int j = 0; j < 4; ++j) { u32x2 o; o.x = cvt_pk_bf16(v[rr][j][0], v[rr][j][1]); o.y = cvt_pk_bf16(v[rr][j][2], v[rr][j][3]); xb[64 * j + lane] = o; } }
            if (lane == 0) ((float*)(P.ws + WS_RSTD))[row] = rstd;
            if ((lane & 7) == 0) { float* dst = row < NPR ? P.out + OFF_LP + ((size_t)l * NPR + row) * NH : P.out + OFF_LS + ((size_t)l * NSR + (row - NPR)) * NH;
                dst[lane >> 3] = logsig_fast(fh[rr] * rstd + bfv); }
        }
#pragma unroll
        for (int rr = 0; rr < 2; ++rr)
#pragma unroll
            for (int j = 0; j < 4; ++j) cur[rr][j] = nxt[rr][j];
    }
#undef XLOAD
}

__device__ __forceinline__ void phase_fix(const Ptrs& P, int l, int gw, int NGW, int lane) {
    const float* halo = (const float*)(P.ws + WS_HALO);
    const float* cw = P.conv_w + (size_t)l * 3 * CONV + 8 * lane;
    for (int it = gw; it < NBLK64 * 2; it += NGW) {
        const int kb = it >> 1, j = it & 1, r = 64 * kb + j; const bool smp = kb >= NPR / 64;
        float um2[8], um1[8], uu[8];
        const float* hus = halo + 2 * HALO_STRIDE + (size_t)kb * 2 * CONV + 8 * lane;
        const float* prev = smp ? P.state_conv + ((size_t)l * DB + (kb - NPR / 64)) * 2 * CONV + 8 * lane : halo + (size_t)(kb - 1) * 2 * CONV + 8 * lane;
        const bool zero = !smp && (kb & 31) == 0;
#pragma unroll
        for (int c = 0; c < 8; ++c) { const float p0 = zero ? 0.f : prev[c], p1 = zero ? 0.f : prev[CONV + c], u0 = hus[c], u1 = hus[CONV + c];
            um2[c] = j == 0 ? p0 : p1; um1[c] = j == 0 ? p1 : u0; uu[c] = j == 0 ? u0 : u1; }
        const float* hb = halo + HALO_STRIDE + ((size_t)kb * 2 + j) * CONV + 8 * lane; const float* hg = halo + 3 * HALO_STRIDE + ((size_t)kb * 2 + j) * CONV + 8 * lane;
        float o[8], ss = 0.f;
#pragma unroll
        for (int c = 0; c < 8; ++c) { const float z = hb[c] * (cw[c] * um2[c] + cw[CONV + c] * um1[c] + cw[2 * CONV + c] * uu[c]); ss += z * z; o[c] = z * hg[c]; }
#pragma unroll
        for (int s = 1; s < 64; s <<= 1) ss += __shfl_xor(ss, s);
        u32x4 w; w.x = cvt_pk_bf16(o[0], o[1]); w.y = cvt_pk_bf16(o[2], o[3]); w.z = cvt_pk_bf16(o[4], o[5]); w.w = cvt_pk_bf16(o[6], o[7]);
        *(u32x4*)((bf16_t*)(P.ws + WS_MIX) + (size_t)r * DM + 512 + 8 * lane) = w;
        if (lane == 0) ((float*)(P.ws + WS_RC))[r] = rsqrtf(ss * (1.f / CONV) + EPS);
    }
    for (int row = gw * 64 + lane; row < NROW; row += NGW * 64) {
        if ((row & 63) >= 2) { const f32x4* c = (const f32x4*)((const float*)(P.ws + WS_CSS) + (size_t)row * 32);
            f32x4 a[8];
#pragma unroll
            for (int i = 0; i < 8; ++i) a[i] = c[i];
            f32x4 t = (a[0] + a[1]) + (a[2] + a[3]); t += (a[4] + a[5]) + (a[6] + a[7]);
            ((float*)(P.ws + WS_RC))[row] = rsqrtf(((t[0] + t[1]) + (t[2] + t[3])) * (1.f / CONV) + EPS); } }
}


constexpr int SKV = PAST + DSEQ;
__device__ __forceinline__ float prune_thr(const Ptrs& P, int l, int lane) {
    float mq = fabsf(P.q_g[l * HD + lane]), mk = fabsf(P.k_g[l * HD + lane]);
#pragma unroll
    for (int o = 1; o < 64; o <<= 1) { mq = fmaxf(mq, __shfl_xor(mq, o)); mk = fmaxf(mk, __shfl_xor(mk, o)); }
    return 2.f * (8.f * mq * mk * LOG2E * 1.02f) + 40.f;
}
__device__ __forceinline__ void phase_scan(const Ptrs& P, int l, int i0, int i1, int rank, int nranks, int tid, LAS unsigned char* lds) {
    LAS float* wtot = (LAS float*)lds;
    LAS float* nbl = (LAS float*)(lds + 64);
    const int lane = tid & 63, wave = tid >> 6;
    const float thr = prune_thr(P, l, lane);
    for (int it = i0 + rank; it < i1; it += nranks) {
        const bool smp = it >= NB * NH; const int bh = smp ? it - NB * NH : it, b = bh >> 3, h = bh & 7, n = smp ? SKV : SEQ;
        float v[5], s = 0.f;
#pragma unroll
        for (int j = 0; j < 5; ++j) { const int e = 5 * tid + j; float x = 0.f;
            if (e < n) { if (!smp) x = P.out[OFF_LP + ((size_t)l * NPR + (size_t)b * SEQ + e) * NH + h];
                         else x = e < PAST ? P.cache_logf[(((size_t)l * DB + b) * PAST + e) * NH + h] : P.out[OFF_LS + ((size_t)l * NSR + (size_t)b * DSEQ + (e - PAST)) * NH + h]; }
            s += x; v[j] = s; }
        float inc = s;
#pragma unroll
        for (int o = 1; o < 64; o <<= 1) { const float t = __shfl_up(inc, o); if (lane >= o) inc += t; }
        __syncthreads();
        if (lane == 63) wtot[wave] = inc;
        __syncthreads();
        float base = inc - s;
        for (int w = 0; w < wave; ++w) base += wtot[w];
        float* dst = smp ? (float*)(P.ws + WS_NBS) + (size_t)bh * SKV : (float*)(P.ws + WS_NBP) + (size_t)bh * SEQ;
#pragma unroll
        for (int j = 0; j < 5; ++j) { const int e = 5 * tid + j; if (e < n) { const float x = -(base + v[j]) * LOG2E; dst[e] = x; if (!smp) nbl[e] = x; } }
        if (!smp) {
            __syncthreads();
            if (tid < 8) { const float lim = nbl[256 * tid] - thr; int i = 0; while (i < 4 * tid && nbl[64 * i + 63] < lim) ++i;
                ((unsigned char*)(P.ws + WS_T0))[bh * 8 + tid] = (unsigned char)(i & ~1); }
        }
    }
    __syncthreads();
}

namespace attn {
using bf16x8 = __attribute__((ext_vector_type(8))) short;
using s16x4 = __attribute__((ext_vector_type(4))) short;
using f32x16 = __attribute__((ext_vector_type(16))) float;
constexpr int D = 64, DMQ = ATT;
constexpr int NW = 8, QBLK = 32, QB = QBLK * NW, KVBLK = 64;
__device__ __forceinline__ int crow(int r, int hi) { return (r & 3) + 8 * (r >> 2) + 4 * hi; }
#define SBAR() __builtin_amdgcn_sched_barrier(0)
__device__ __forceinline__ void cmask(f32x16& p0, f32x16& p1, int jb, int qrel, int hi) {
    const float NEG = -INFINITY; int kb = 64 * jb + 4 * hi;
#pragma unroll
    for (int r = 0; r < 16; ++r) { int kv = kb + (r & 3) + 8 * (r >> 2); if (kv > qrel) p0[r] = NEG; if (kv + 32 > qrel) p1[r] = NEG; }
}
constexpr int NSLOT = 3, SLOTB = 8192;
constexpr int LDS_K = 0, LDS_V = NSLOT * SLOTB, LDS_WS = 2 * NSLOT * SLOTB, LDS_NB = LDS_WS + NW * 64 * 4, LDS_OST = LDS_NB + SEQ * 4, LDS_ATT_BYTES = LDS_OST + NW * 8192;
static_assert(LDS_ATT_BYTES <= RING_BYTES, "attention scratch fits the ring region");
__device__ __forceinline__ void glds16(const void* gsrc, unsigned lds_dst) { unsigned keep;
    asm volatile("s_mov_b32 %0, m0\n\ts_mov_b32 m0, %2\n\ts_nop 0\n\tglobal_load_lds_dwordx4 %1, off\n\ts_mov_b32 m0, %0" : "=&s"(keep) : "v"(gsrc), "s"(lds_dst) : "memory"); }
__device__ __forceinline__ float max3f(float a, float b, float c) { float r; asm("v_max3_f32 %0, %1, %2, %3" : "=v"(r) : "v"(a), "v"(b), "v"(c)); return r; }
__device__ __forceinline__ float max2f(float a, float b) { float r; asm("v_max_f32_e32 %0, %1, %2" : "=v"(r) : "v"(a), "v"(b)); return r; }
__device__ __forceinline__ float fadd_s(float a, float b) { float r; asm("v_add_f32_e32 %0, %1, %2" : "=v"(r) : "v"(a), "v"(b)); return r; }
__device__ __forceinline__ float fsub_s(float a, float b) { float r; asm("v_sub_f32_e32 %0, %1, %2" : "=v"(r) : "v"(a), "v"(b)); return r; }
typedef float f32x2_t __attribute__((ext_vector_type(2))); typedef __bf16 bf16x2_t __attribute__((ext_vector_type(2)));
__device__ __forceinline__ unsigned cvtpk_s(float lo, float hi) { f32x2_t v = {lo, hi}; bf16x2_t b = __builtin_convertvector(v, bf16x2_t); return __builtin_bit_cast(unsigned, b); }
#define WAIT_BAR(N) asm volatile("s_waitcnt vmcnt(" #N ") lgkmcnt(0)\n\ts_barrier" ::: "memory")
typedef __attribute__((address_space(3))) const char* lds_cptr;
typedef short v4i16_t __attribute__((ext_vector_type(4)));
__device__ __forceinline__ void kload8(bf16x8* kf, lds_cptr kp) {
    kf[0] = *(const LAS bf16x8*)(kp);        kf[1] = *(const LAS bf16x8*)(kp + 512);
    kf[2] = *(const LAS bf16x8*)(kp + 2048); kf[3] = *(const LAS bf16x8*)(kp + 2560);
    kf[4] = *(const LAS bf16x8*)(kp + 4096); kf[5] = *(const LAS bf16x8*)(kp + 4608);
    kf[6] = *(const LAS bf16x8*)(kp + 6144); kf[7] = *(const LAS bf16x8*)(kp + 6656);
}
__device__ __forceinline__ void kload2(bf16x8* kf, lds_cptr kp, int j) { kf[2 * j] = *(const LAS bf16x8*)(kp + j * 2048); kf[2 * j + 1] = *(const LAS bf16x8*)(kp + j * 2048 + 512); }
__device__ __forceinline__ s16x4 vtr(lds_cptr p) { return __builtin_bit_cast(s16x4, __builtin_amdgcn_ds_read_tr16_b64_v4i16((LAS v4i16_t*)p)); }
__device__ __forceinline__ float rowmax(const f32x16& p0, const f32x16& p1) {
    float a = max3f(p0[0], p0[1], p1[0]), b = max3f(p0[2], p0[3], p1[1]); a = max3f(a, p1[2], p1[3]);
#pragma unroll
    for (int r = 4; r < 16; r += 4) { a = max3f(a, p0[r], p0[r + 1]); b = max3f(b, p0[r + 2], p0[r + 3]); a = max3f(a, p1[r], p1[r + 1]); b = max3f(b, p1[r + 2], p1[r + 3]); }
    const float m = max2f(a, b);
    auto rr = __builtin_amdgcn_permlane32_swap(__float_as_uint(m), __float_as_uint(m), false, false);
    return max2f(__uint_as_float(rr[0]), __uint_as_float(rr[1]));
}
__device__ __forceinline__ void pv(f32x16* o, int vb, bf16x8 pa0, bf16x8 pa1, bf16x8 pa2, bf16x8 pa3) {
#pragma unroll
    for (int d0 = 0; d0 < 2; ++d0) { s16x4 lo[4], hi[4];
#pragma unroll
        for (int ks = 0; ks < 4; ++ks) {
            asm volatile("ds_read_b64_tr_b16 %0,%1 offset:%c2" : "=&v"(lo[ks]) : "v"(vb), "i"(d0 * 4096 + ks * 1024) : "memory");
            asm volatile("ds_read_b64_tr_b16 %0,%1 offset:%c2" : "=&v"(hi[ks]) : "v"(vb), "i"(d0 * 4096 + ks * 1024 + 512) : "memory"); }
        asm volatile("s_waitcnt lgkmcnt(0)" ::: "memory"); SBAR();
#define PK(k) (bf16x8){lo[k][0], lo[k][1], lo[k][2], lo[k][3], hi[k][0], hi[k][1], hi[k][2], hi[k][3]}
        o[d0] = __builtin_amdgcn_mfma_f32_32x32x16_bf16(pa0, PK(0), o[d0], 0, 0, 0);
        o[d0] = __builtin_amdgcn_mfma_f32_32x32x16_bf16(pa1, PK(1), o[d0], 0, 0, 0);
        o[d0] = __builtin_amdgcn_mfma_f32_32x32x16_bf16(pa2, PK(2), o[d0], 0, 0, 0);
        o[d0] = __builtin_amdgcn_mfma_f32_32x32x16_bf16(pa3, PK(3), o[d0], 0, 0, 0);
#undef PK
    }
}

template <int THRL> __device__ __forceinline__ void attn_unit(const Ptrs& P, int l, int b, int h, int qb, const int T0, const float Mb, unsigned* qctr, volatile LAS unsigned* slot, char* shm, int tid) {
    asm volatile("" : "+v"(tid));
    const int lane = tid & 63, r32 = lane & 31, hi = lane >> 5; const int wid = __builtin_amdgcn_readfirstlane(tid >> 6);
    const bf16_t* Q = (const bf16_t*)(P.ws + WS_Q); const bf16_t* K = (const bf16_t*)(P.ws + WS_KB); const bf16_t* V = (const bf16_t*)(P.ws + WS_VB);
    const long rowbase = (long)b * SEQ; const int q0 = qb * QB;
    const bf16_t* Qw = Q + (rowbase + q0 + wid * QBLK) * DMQ + h * D;
    const bf16_t* Kh = K + rowbase * DMQ + h * D, *Vh = V + rowbase * DMQ + h * D;
    const unsigned lds0 = (unsigned)(uintptr_t)shm;
    float* wsf = (float*)(shm + LDS_WS) + wid * 64;
    const float* nbg = (const float*)(P.ws + WS_NBP) + (size_t)(b * NH + h) * SEQ;
    const bf16_t* ksrc = K + ((long)(b * NH + h) * 32 + T0) * 4096 + wid * 512 + lane * 8;
    const bf16_t* vsrc = V + ((long)(b * NH + h) * 32 + T0) * 4096 + wid * 512 + lane * 8;
    const unsigned kdst = lds0 + LDS_K + wid * 1024, vdst = lds0 + LDS_V + wid * 1024;
#define DMA_K(t, slot) glds16(ksrc + (long)(t) * 4096, (unsigned)__builtin_amdgcn_readfirstlane(kdst + (slot)))
#define DMA_V(t, slot) glds16(vsrc + (long)(t) * 4096, (unsigned)__builtin_amdgcn_readfirstlane(vdst + (slot)))
    const int vb0 = (int)(lds0 + LDS_V) + ((lane >> 4) & 1) * 32 + (lane & 3) * 8 + (4 * hi + ((lane & 15) >> 2)) * 64;
    bf16x8 kf[8];
    const lds_cptr shm3 = (lds_cptr)shm; const lds_cptr kp0 = shm3 + LDS_K + hi * 1024 + r32 * 16; const lds_cptr vp0 = shm3 + LDS_V + ((lane >> 4) & 1) * 32 + (lane & 3) * 8 + (4 * hi + ((lane & 15) >> 2)) * 64;
    const lds_cptr nb3 = shm3 + LDS_NB + 16 * hi + 256 * T0;
    const lds_cptr nbl0 = shm3 + LDS_NB + 256 * T0 + 252;
    const int NT = (q0 + QB) / KVBLK - T0;
    const int xd4 = tid & 15, xkq = tid >> 4;
    const lds_cptr xk0 = shm3 + LDS_K + (xd4 >> 1) * 1024 + xkq * 16 + (xd4 & 1) * 8;
    const lds_cptr xv0 = shm3 + LDS_V + (xd4 >> 3) * 4096 + xkq * 64 + (xd4 & 7) * 8;
    float* const xko = P.out + OFF_KP + ((size_t)l * NPR + rowbase + 64 * T0 + xkq) * ATT + h * D + 4 * xd4;
#define XPAND(src, pstride, dst) do { _Pragma("unroll") for (int ps_ = 0; ps_ < 2; ++ps_) { const u32x2 w_ = *(const LAS u32x2*)((src) + ps_ * (pstride)); \
        const f32x4 x_ = (f32x4){bf2f(w_.x & 0xffffu), __builtin_bit_cast(float, w_.x & 0xffff0000u), bf2f(w_.y & 0xffffu), __builtin_bit_cast(float, w_.y & 0xffff0000u)}; \
        __builtin_nontemporal_store(x_, (f32x4*)((dst) + (size_t)(32 * ps_) * ATT)); } } while (0)
#define XP(t) do { if ((t) + 1 >= NT - 4 && (t) + 1 < NT) XPAND(xk0 + sl_next, 512, xko + (size_t)(64 * ((t) + 1)) * ATT); \
                   if ((t) - 1 >= NT - 4) XPAND(xv0 + sl_prev, 2048, xko + (OFF_VP - OFF_KP) + (size_t)(64 * ((t) - 1)) * ATT); } while (0)
    DMA_K(0, 0); DMA_V(0, 0); DMA_K(1, SLOTB);
    { const int e = 64 * T0 + 4 * tid;
      if (e < q0 + QB) { const f32x4 x = *(const f32x4*)(nbg + e); *(LAS f32x4*)((LAS char*)shm3 + LDS_NB + 4 * e) = x; } }
    bf16x8 qr[4];
#pragma unroll
    for (int d0 = 0; d0 < 4; ++d0) qr[d0] = *reinterpret_cast<const bf16x8*>(&Qw[(long)r32 * DMQ + d0 * 16 + hi * 8]);
    float mhat = 0.f, l_reg = 0.f; f32x16 o[2]; o[0] = f32x16{}; o[1] = f32x16{};
    const int qrel = wid * QBLK + r32;
#define CMASK(P0, P1, t) do { int jb_ = (t) - (NT - 4); if (jb_ >= 0) cmask(P0, P1, jb_, qrel, hi); } while (0)
    u32x4 qmw = (u32x4){0u, 0u, 0u, 0u};
    const u32x4 konew = hi == 0 ? (u32x4){0x3F803F80u, 0x00003F80u, 0u, 0u} : (u32x4){0u, 0u, 0u, 0u};
#define SETQM() do { const unsigned a_ = cvtpk_s(mhat, 0.f) & 0xffffu; const float r1_ = mhat - __uint_as_float(a_ << 16); \
      const unsigned b_ = cvtpk_s(r1_, 0.f) & 0xffffu; const float r2_ = r1_ - __uint_as_float(b_ << 16); const unsigned c_ = cvtpk_s(r2_, 0.f) & 0xffffu; \
      qmw.x = hi == 0 ? ((a_ | (b_ << 16)) ^ 0x80008000u) : 0u; qmw.y = hi == 0 ? (c_ ^ 0x8000u) : 0u; } while (0)
#define REFMM(C0, C1) do { C0 = __builtin_amdgcn_mfma_f32_32x32x16_bf16(__builtin_bit_cast(bf16x8, konew), __builtin_bit_cast(bf16x8, qmw), C0, 0, 0, 0); \
      C1 = __builtin_amdgcn_mfma_f32_32x32x16_bf16(__builtin_bit_cast(bf16x8, konew), __builtin_bit_cast(bf16x8, qmw), C1, 0, 0, 0); } while (0)
#define BIAS(C0, C1, t) do { const lds_cptr nbp_ = nb3 + 256 * (t); \
      _Pragma("unroll") for (int g_ = 0; g_ < 4; ++g_) { const f32x4 x_ = *(const LAS f32x4*)(nbp_ + 32 * g_), y_ = *(const LAS f32x4*)(nbp_ + 128 + 32 * g_); \
        _Pragma("unroll") for (int j_ = 0; j_ < 4; ++j_) { C0[4 * g_ + j_] = x_[j_]; C1[4 * g_ + j_] = y_[j_]; } } } while (0)
    bool resc = false;
#define START(P0, P1) do { const float rm = rowmax(P0, P1); resc = false; \
    { const float dl = rm; mhat = fadd_s(mhat, dl); SETQM(); \
      _Pragma("unroll") for (int r = 0; r < 16; ++r) { P0[r] = fsub_s(P0[r], dl); P1[r] = fsub_s(P1[r], dl); } } \
    _Pragma("unroll") for (int r = 0; r < 16; ++r) P0[r] = __builtin_amdgcn_exp2f(P0[r]); } while (0)
#define RESC() do { if (resc) { asm volatile("s_waitcnt lgkmcnt(0)" ::: "memory"); \
      _Pragma("unroll") for (int d_ = 0; d_ < 2; ++d_) _Pragma("unroll") for (int r = 0; r < 16; ++r) o[d_][r] *= wsf[crow(r, hi)]; } } while (0)
    f32x16 pA0, pA1, pB0, pB1;
    int sl_prev = 0, sl_cur = 0, sl_next = SLOTB;
#define ROT() do { sl_prev = sl_cur; sl_cur = sl_next; sl_next = (sl_next == (NSLOT - 1) * SLOTB) ? 0 : sl_next + SLOTB; } while (0)
    DMA_K(2, 2 * SLOTB);
    WAIT_BAR(3);
    if (NT == 4) XPAND(xk0, 512, xko);
    BIAS(pA0, pA1, 0);
    { const char* kb = shm + LDS_K + hi * 1024 + r32 * 16;
#pragma unroll
      for (int d0 = 0; d0 < 4; ++d0) { const bf16x8 b0 = *reinterpret_cast<const bf16x8*>(kb + d0 * 2048); const bf16x8 b1 = *reinterpret_cast<const bf16x8*>(kb + d0 * 2048 + 512);
        pA0 = __builtin_amdgcn_mfma_f32_32x32x16_bf16(b0, qr[d0], pA0, 0, 0, 0); pA1 = __builtin_amdgcn_mfma_f32_32x32x16_bf16(b1, qr[d0], pA1, 0, 0, 0); } }
    asm volatile("s_nop 15\n\ts_nop 7" : "+v"(pA0), "+v"(pA1)); CMASK(pA0, pA1, 0);
    START(pA0, pA1);
    _Pragma("unroll") for (int r = 0; r < 16; ++r) pA1[r] = __builtin_amdgcn_exp2f(pA1[r]);
    WAIT_BAR(0);
    if (NT == 4) XPAND(xk0 + SLOTB, 512, xko + (size_t)64 * ATT);
    DMA_K(3, 0); DMA_V(1, SLOTB);
    ROT();
    kload8(kf, kp0 + sl_cur);
    WAIT_BAR(2);
    s16x4 vlo[8], vhi[8]; u32x4 pw0, pw1, pw2, pw3;
#define PKW(P, B) cvtpk_s(P[B], P[B + 1])
#define PAF(k) __builtin_bit_cast(bf16x8, pw##k)
#define VFR(i) (bf16x8){vlo[i][0], vlo[i][1], vlo[i][2], vlo[i][3], vhi[i][0], vhi[i][1], vhi[i][2], vhi[i][3]}
#define PIN(x) asm volatile("" : "+v"(x))
#define MX3(a, b, c) __builtin_fmaxf(__builtin_fmaxf((a), (b)), (c))
#define GAPA(MF, A0, A1, A2, A3, W0, W1, PW) do { MF; sacc += A0; sacc += A1; sacc += A2; sacc += A3; PIN(sacc); W0; W1; PIN(PW); SBAR(); } while (0)
#define EX(v) __builtin_amdgcn_exp2f(v)
#define GAPB(MF, X, B) do { MF; X[B] = EX(X[B]); X[B + 1] = EX(X[B + 1]); X[B + 2] = EX(X[B + 2]); X[B + 3] = EX(X[B + 3]); PIN(X); SBAR(); } while (0)
#define VRD(i) do { vlo[i] = vtr(vp_ + (((i) >> 2) * 4096 + ((i) & 3) * 1024)); vhi[i] = vtr(vp_ + (((i) >> 2) * 4096 + ((i) & 3) * 1024 + 512)); } while (0)
#define KRD(G, j) do { if (G) { kload2(kf, kp0 + sl_next, j); SBAR(); } } while (0)
#define STEP(C0, C1, P0, P1, t, GK, GV, GL) do { SBAR(); \
    BIAS(C0, C1, t); SBAR(); REFMM(C0, C1); SBAR(); \
    const lds_cptr vp_ = vp0 + sl_prev; \
    VRD(0); SBAR(); float sacc = (P0[0] + P0[1]); \
    GAPA(C0 = __builtin_amdgcn_mfma_f32_32x32x16_bf16(kf[0], qr[0], C0, 0, 0, 0), P0[2], P0[3], P0[4], P0[5],     pw0[0] = PKW(P0, 0), pw0[1] = PKW(P0, 2), pw0); \
    VRD(4); SBAR(); GAPA(C1 = __builtin_amdgcn_mfma_f32_32x32x16_bf16(kf[1], qr[0], C1, 0, 0, 0), P0[6], P0[7], P0[8], P0[9],     pw0[2] = PKW(P0, 4), pw0[3] = PKW(P0, 6), pw0); \
    VRD(1); SBAR(); GAPA(C0 = __builtin_amdgcn_mfma_f32_32x32x16_bf16(kf[2], qr[1], C0, 0, 0, 0),   P0[10], P0[11], P0[12], P0[13], pw1[0] = PKW(P0, 8), pw1[1] = PKW(P0, 10), pw1); \
    VRD(5); SBAR(); GAPA(C1 = __builtin_amdgcn_mfma_f32_32x32x16_bf16(kf[3], qr[1], C1, 0, 0, 0),   P0[14], P0[15], P1[0], P1[1],   pw1[2] = PKW(P0, 12), pw1[3] = PKW(P0, 14), pw1); \
    VRD(2); SBAR(); GAPA(C0 = __builtin_amdgcn_mfma_f32_32x32x16_bf16(kf[4], qr[2], C0, 0, 0, 0),   P1[2], P1[3], P1[4], P1[5],     pw2[0] = PKW(P1, 0), pw2[1] = PKW(P1, 2), pw2); \
    VRD(6); SBAR(); GAPA(C1 = __builtin_amdgcn_mfma_f32_32x32x16_bf16(kf[5], qr[2], C1, 0, 0, 0),   P1[6], P1[7], P1[8], P1[9],     pw2[2] = PKW(P1, 4), pw2[3] = PKW(P1, 6), pw2); \
    VRD(3); SBAR(); GAPA(C0 = __builtin_amdgcn_mfma_f32_32x32x16_bf16(kf[6], qr[3], C0, 0, 0, 0),   P1[10], P1[11], P1[12], P1[13], pw3[0] = PKW(P1, 8), pw3[1] = PKW(P1, 10), pw3); \
    VRD(7); SBAR(); GAPA(C1 = __builtin_amdgcn_mfma_f32_32x32x16_bf16(kf[7], qr[3], C1, 0, 0, 0),   P1[14], P1[15], 0.f, 0.f,       pw3[2] = PKW(P1, 12), pw3[3] = PKW(P1, 14), pw3); \
    l_reg += sacc; \
    if (GK) { DMA_K((t) + 3, sl_cur); } if (GV) { DMA_V((t) + 1, sl_next); } \
    CMASK(C0, C1, t); \
    resc = false; \
      \
    if (__builtin_expect(__any(*(const LAS float*)(nbl0 + 256 * (t)) + Mb - mhat > 48.f), 0)) { \
      float a = MX3(C0[0], C0[1], C1[0]), b = MX3(C0[2], C0[3], C1[1]); a = MX3(a, C1[2], C1[3]); \
      _Pragma("unroll") for (int r = 4; r < 16; r += 4) { a = MX3(a, C0[r], C0[r + 1]); b = MX3(b, C0[r + 2], C0[r + 3]); a = MX3(a, C1[r], C1[r + 1]); b = MX3(b, C1[r + 2], C1[r + 3]); } \
      float rm = __builtin_fmaxf(a, b); { auto rr = __builtin_amdgcn_permlane32_swap(__float_as_uint(rm), __float_as_uint(rm), false, false); rm = __builtin_fmaxf(__uint_as_float(rr[0]), __uint_as_float(rr[1])); } \
      if (__builtin_expect(__any(rm > (float)THRL), 0)) { const float dl = __builtin_fmaxf(rm, 0.f); mhat += dl; SETQM(); \
        _Pragma("unroll") for (int r = 0; r < 16; ++r) { C0[r] -= dl; C1[r] -= dl; } \
        const float f = __builtin_amdgcn_exp2f(-dl); l_reg *= f; if (hi == 0) wsf[r32] = f; resc = true; } } \
    SBAR(); \
    GAPB(o[0] = __builtin_amdgcn_mfma_f32_32x32x16_bf16(PAF(0), VFR(0), o[0], 0, 0, 0), C0, 0); \
    GAPB(o[1] = __builtin_amdgcn_mfma_f32_32x32x16_bf16(PAF(0), VFR(4), o[1], 0, 0, 0), C0, 4); \
    KRD(GL, 0); GAPB(o[0] = __builtin_amdgcn_mfma_f32_32x32x16_bf16(PAF(1), VFR(1), o[0], 0, 0, 0), C0, 8); \
    KRD(GL, 1); GAPB(o[1] = __builtin_amdgcn_mfma_f32_32x32x16_bf16(PAF(1), VFR(5), o[1], 0, 0, 0), C0, 12); \
    KRD(GL, 2); GAPB(o[0] = __builtin_amdgcn_mfma_f32_32x32x16_bf16(PAF(2), VFR(2), o[0], 0, 0, 0), C1, 0); \
    KRD(GL, 3); GAPB(o[1] = __builtin_amdgcn_mfma_f32_32x32x16_bf16(PAF(2), VFR(6), o[1], 0, 0, 0), C1, 4); \
    GAPB(o[0] = __builtin_amdgcn_mfma_f32_32x32x16_bf16(PAF(3), VFR(3), o[0], 0, 0, 0), C1, 8); \
    GAPB(o[1] = __builtin_amdgcn_mfma_f32_32x32x16_bf16(PAF(3), VFR(7), o[1], 0, 0, 0), C1, 12); \
    } while (0)
    int t = 1;
#undef CMASK
#define CMASK(P0, P1, t) do {} while (0)
    for (; t + 5 < NT; t += 2) {
        STEP(pB0, pB1, pA0, pA1, t, true, true, true);     WAIT_BAR(2); RESC(); ROT();
        STEP(pA0, pA1, pB0, pB1, t + 1, true, true, true); WAIT_BAR(2); RESC(); ROT();
    }
#undef CMASK
#define CMASK(P0, P1, t) do { int jb_ = (t) - (NT - 4); if (jb_ >= 0) cmask(P0, P1, jb_, qrel, hi); } while (0)
#define ENDW(tt) do { if ((tt) + 3 < NT) { WAIT_BAR(2); } else if ((tt) + 2 < NT) { WAIT_BAR(1); } else { WAIT_BAR(0); } } while (0)
    for (; t + 1 < NT; t += 2) {
        XP(t);     STEP(pB0, pB1, pA0, pA1, t, (t + 3 < NT), (t + 1 < NT), (t + 1 < NT));         ENDW(t);     RESC(); ROT();
        XP(t + 1); STEP(pA0, pA1, pB0, pB1, t + 1, (t + 4 < NT), (t + 2 < NT), (t + 2 < NT));     ENDW(t + 1); RESC(); ROT();
    }
    XP(NT - 1); XPAND(xv0 + sl_cur, 2048, xko + (OFF_VP - OFF_KP) + (size_t)(64 * (NT - 1)) * ATT);
    STEP(pB0, pB1, pA0, pA1, NT - 1, false, false, false); RESC();
    { float sacc = pB0[0] + pB0[1]; _Pragma("unroll") for (int r = 2; r < 16; ++r) sacc += pB0[r]; _Pragma("unroll") for (int r = 0; r < 16; ++r) sacc += pB1[r]; l_reg += sacc;
      pw0 = (u32x4){PKW(pB0, 0), PKW(pB0, 2), PKW(pB0, 4), PKW(pB0, 6)}; pw1 = (u32x4){PKW(pB0, 8), PKW(pB0, 10), PKW(pB0, 12), PKW(pB0, 14)}; pw2 = (u32x4){PKW(pB1, 0), PKW(pB1, 2), PKW(pB1, 4), PKW(pB1, 6)}; pw3 = (u32x4){PKW(pB1, 8), PKW(pB1, 10), PKW(pB1, 12), PKW(pB1, 14)};
      SBAR(); pv(o, vb0 + sl_cur, PAF(0), PAF(1), PAF(2), PAF(3)); }
#undef PKW
#undef PAF
#undef VFR
#undef PIN
#undef MX3
#undef GAPA
#undef GAPB
#undef EX
#undef VRD
#undef KRD
#undef STEP
#undef ENDW
    unsigned nxu = 0; if (tid == 0) nxu = __hip_atomic_fetch_add(qctr, 1u, __ATOMIC_RELAXED, __HIP_MEMORY_SCOPE_AGENT);
    const long grow0 = rowbase + q0 + wid * QBLK;
    u32x4 gav[4];
#pragma unroll
    for (int i = 0; i < 4; ++i) gav[i] = __builtin_nontemporal_load((const u32x4*)((const bf16_t*)(P.ws + WS_GA) + (grow0 + i * 8 + (lane >> 3)) * ATT + h * D + (lane & 7) * 8));
    { auto rr = __builtin_amdgcn_permlane32_swap(__float_as_uint(l_reg), __float_as_uint(l_reg), false, false); l_reg = __uint_as_float(rr[0]) + __uint_as_float(rr[1]); }
    if (hi == 0) wsf[32 + r32] = l_reg; asm volatile("s_waitcnt lgkmcnt(0)" ::: "memory");
    float rli[16];
#pragma unroll
    for (int r = 0; r < 16; ++r) rli[r] = __builtin_amdgcn_rcpf(wsf[32 + crow(r, hi)]);
    { float* stg = (float*)(shm + LDS_OST) + wid * 2048;
#pragma unroll
      for (int r = 0; r < 16; ++r) { const int orow = crow(r, hi);
#pragma unroll
        for (int d0 = 0; d0 < 2; ++d0) stg[orow * 64 + d0 * 32 + r32] = o[d0][r] * rli[r]; }
      asm volatile("s_waitcnt lgkmcnt(0)" ::: "memory");
      f32x4 sa0[4], sa1[4];
#pragma unroll
      for (int i = 0; i < 4; ++i) { const int row = i * 8 + (lane >> 3), ch = lane & 7; sa0[i] = *(const f32x4*)(stg + row * 64 + ch * 8); sa1[i] = *(const f32x4*)(stg + row * 64 + ch * 8 + 4); }
#pragma unroll
      for (int i = 0; i < 4; ++i) { const int row = i * 8 + (lane >> 3), ch = lane & 7; const long grow = grow0 + row;
        const f32x4 a0 = sa0[i], a1 = sa1[i];
        float ss = ((a0[0] * a0[0] + a0[1] * a0[1]) + (a0[2] * a0[2] + a0[3] * a0[3])) + ((a1[0] * a1[0] + a1[1] * a1[1]) + (a1[2] * a1[2] + a1[3] * a1[3]));
        { float r_; asm("s_nop 1\n\tv_add_f32_dpp %0, %1, %1 row_shl:4 row_mask:0xf bank_mask:0xf bound_ctrl:1" : "=&v"(r_) : "v"(ss)); ss = r_;
          asm("s_nop 1\n\tv_add_f32_dpp %0, %1, %1 row_shl:2 row_mask:0xf bank_mask:0xf bound_ctrl:1" : "=&v"(r_) : "v"(ss)); ss = r_;
          asm("s_nop 1\n\tv_add_f32_dpp %0, %1, %1 row_shl:1 row_mask:0xf bank_mask:0xf bound_ctrl:1" : "=&v"(r_) : "v"(ss)); ss = r_; }
        const u32x4 g = gav[i];
        u32x4 w;
        w.x = cvt_pk_bf16(a0[0] * bf2f(g.x & 0xffffu), a0[1] * bf2f(g.x >> 16)); w.y = cvt_pk_bf16(a0[2] * bf2f(g.y & 0xffffu), a0[3] * bf2f(g.y >> 16));
        w.z = cvt_pk_bf16(a1[0] * bf2f(g.z & 0xffffu), a1[1] * bf2f(g.z >> 16)); w.w = cvt_pk_bf16(a1[2] * bf2f(g.w & 0xffffu), a1[3] * bf2f(g.w >> 16));
        *(u32x4*)((bf16_t*)(P.ws + WS_MIX) + grow * DM + h * D + ch * 8) = w;
        if (ch == 0) ((float*)(P.ws + WS_ASS))[grow * NH + h] = ss; } }
    if (tid == 0) *slot = nxu;
    asm volatile("s_waitcnt lgkmcnt(0)\n\ts_barrier" ::: "memory");
#undef XP
#undef XPAND
#undef SETQM
#undef REFMM
#undef DMA_K
#undef DMA_V
#undef CMASK
#undef BIAS
#undef START
#undef RESC
#undef ROT
}
#undef SBAR
#undef WAIT_BAR
}

namespace sattn {
using bf16x8 = __attribute__((ext_vector_type(8))) short;
using f32x16 = __attribute__((ext_vector_type(16))) float;
constexpr int S_NB = 0, S_WS = 8704, S_ML = 10752, S_OP = 14848, S_END = S_OP + 131072;
static_assert(S_END <= LDS_BYTES, "sample attention LDS");
__device__ __forceinline__ int crow(int r, int hi) { return (r & 3) + 8 * (r >> 2) + 4 * hi; }
__device__ __forceinline__ bf16x8 pack8(const f32x4 a, const f32x4 c) { u32x4 w; w.x = cvt_pk_bf16(a[0], a[1]); w.y = cvt_pk_bf16(a[2], a[3]); w.z = cvt_pk_bf16(c[0], c[1]); w.w = cvt_pk_bf16(c[2], c[3]); return __builtin_bit_cast(bf16x8, w); }
__device__ __forceinline__ float halfmax(float m) { auto rr = __builtin_amdgcn_permlane32_swap(__float_as_uint(m), __float_as_uint(m), false, false); return fmaxf(__uint_as_float(rr[0]), __uint_as_float(rr[1])); }
__device__ __forceinline__ void unit(const Ptrs& P, int l, int b, int h, char* shm, int tid) {
    asm volatile("" : "+v"(tid));
    const int lane = tid & 63, r32 = lane & 31, hi = lane >> 5; const int wid = __builtin_amdgcn_readfirstlane(tid >> 6);
    const int bh = b * NH + h; const size_t srow0 = (size_t)NPR + (size_t)b * DSEQ;
    { const float* nbg = (const float*)(P.ws + WS_NBS) + (size_t)bh * SKV;
      for (int i = tid; i < SKV / 4; i += NWAVES * 64) *(f32x4*)(shm + S_NB + 16 * i) = *(const f32x4*)(nbg + 4 * i); }
    const bf16_t* Qg = (const bf16_t*)(P.ws + WS_Q) + srow0 * ATT + h * HD;
    bf16x8 qr[2][4];
#pragma unroll
    for (int qb = 0; qb < 2; ++qb)
#pragma unroll
        for (int d0 = 0; d0 < 4; ++d0) qr[qb][d0] = *(const bf16x8*)(Qg + (size_t)(32 * qb + r32) * ATT + 16 * d0 + 8 * hi);
    f32x16 o[2][2];
#pragma unroll
    for (int qb = 0; qb < 2; ++qb)
#pragma unroll
        for (int d0 = 0; d0 < 2; ++d0) o[qb][d0] = f32x16{};
    float mref[2] = {0.f, 0.f}, lsum[2] = {0.f, 0.f};
    float* wsf = (float*)(shm + S_WS) + wid * 64;
    const float* ckb = P.cache_k + (((size_t)l * DB + b) * PAST) * ATT + h * HD; const float* cvb = P.cache_v + (((size_t)l * DB + b) * PAST) * ATT + h * HD;
    const bf16_t* Kn = (const bf16_t*)(P.ws + WS_KB) + srow0 * ATT + h * HD; const bf16_t* Vn = (const bf16_t*)(P.ws + WS_VB) + srow0 * ATT + h * HD;
    __syncthreads();
    for (int j = wid; j < SKV / 32; j += NWAVES) {
        const int kv0 = 32 * j; const bool cached = j < PAST / 32;
        bf16x8 kf[4], vf[2][2];
        if (cached) {
            const float* kp = ckb + (size_t)(kv0 + r32) * ATT + 8 * hi;
#pragma unroll
            for (int d0 = 0; d0 < 4; ++d0) kf[d0] = pack8(*(const f32x4*)(kp + 16 * d0), *(const f32x4*)(kp + 16 * d0 + 4));
#pragma unroll
            for (int ks = 0; ks < 2; ++ks)
#pragma unroll
                for (int d0 = 0; d0 < 2; ++d0) { const float* vp = cvb + (size_t)(kv0 + 16 * ks + 4 * hi) * ATT + 32 * d0 + r32;
                    f32x4 a, c;
#pragma unroll
                    for (int jj = 0; jj < 4; ++jj) { a[jj] = vp[(size_t)jj * ATT]; c[jj] = vp[(size_t)(8 + jj) * ATT]; }
                    vf[ks][d0] = pack8(a, c); }
        } else {
            const int kn0 = kv0 - PAST;
#pragma unroll
            for (int d0 = 0; d0 < 4; ++d0) kf[d0] = *(const bf16x8*)(Kn + (size_t)(kn0 + r32) * ATT + 16 * d0 + 8 * hi);
#pragma unroll
            for (int ks = 0; ks < 2; ++ks)
#pragma unroll
                for (int d0 = 0; d0 < 2; ++d0) { const bf16_t* vp = Vn + (size_t)(kn0 + 16 * ks + 4 * hi) * ATT + 32 * d0 + r32;
                    bf16x8 x;
#pragma unroll
                    for (int jj = 0; jj < 4; ++jj) { x[jj] = (short)vp[(size_t)jj * ATT]; x[4 + jj] = (short)vp[(size_t)(8 + jj) * ATT]; }
                    vf[ks][d0] = x; }
        }
        f32x16 p[2];
#pragma unroll
        for (int g = 0; g < 4; ++g) { const f32x4 x = *(const f32x4*)(shm + S_NB + 4 * (kv0 + 8 * g + 4 * hi));
#pragma unroll
            for (int jj = 0; jj < 4; ++jj) { p[0][4 * g + jj] = x[jj] - mref[0]; p[1][4 * g + jj] = x[jj] - mref[1]; } }
#pragma unroll
        for (int qb = 0; qb < 2; ++qb)
#pragma unroll
            for (int d0 = 0; d0 < 4; ++d0) p[qb] = __builtin_amdgcn_mfma_f32_32x32x16_bf16(kf[d0], qr[qb][d0], p[qb], 0, 0, 0);
        if (!cached) { const int kn0 = kv0 - PAST;
#pragma unroll
            for (int qb = 0; qb < 2; ++qb)
#pragma unroll
                for (int r = 0; r < 16; ++r) if (kn0 + crow(r, hi) > 32 * qb + r32) p[qb][r] = -INFINITY; }
        bf16x8 pa[2][2];
#pragma unroll
        for (int qb = 0; qb < 2; ++qb) {
            float rm = p[qb][0];
#pragma unroll
            for (int r = 1; r < 16; ++r) rm = fmaxf(rm, p[qb][r]);
            rm = halfmax(rm);
            if (__any(rm > 8.f)) { const float dl = fmaxf(rm, 0.f); mref[qb] += dl;
#pragma unroll
                for (int r = 0; r < 16; ++r) p[qb][r] -= dl;
                const float f = __builtin_amdgcn_exp2f(-dl); lsum[qb] *= f; if (hi == 0) wsf[32 * qb + r32] = f;
#pragma unroll
                for (int r = 0; r < 16; ++r) { const float fr = wsf[32 * qb + crow(r, hi)]; o[qb][0][r] *= fr; o[qb][1][r] *= fr; } }
            float s = 0.f;
#pragma unroll
            for (int r = 0; r < 16; ++r) { p[qb][r] = __builtin_amdgcn_exp2f(p[qb][r]); s += p[qb][r]; }
            lsum[qb] += s;
#pragma unroll
            for (int ks = 0; ks < 2; ++ks) pa[qb][ks] = pack8((f32x4){p[qb][8 * ks], p[qb][8 * ks + 1], p[qb][8 * ks + 2], p[qb][8 * ks + 3]}, (f32x4){p[qb][8 * ks + 4], p[qb][8 * ks + 5], p[qb][8 * ks + 6], p[qb][8 * ks + 7]});
        }
#pragma unroll
        for (int qb = 0; qb < 2; ++qb)
#pragma unroll
            for (int d0 = 0; d0 < 2; ++d0)
#pragma unroll
                for (int ks = 0; ks < 2; ++ks) o[qb][d0] = __builtin_amdgcn_mfma_f32_32x32x16_bf16(pa[qb][ks], vf[ks][d0], o[qb][d0], 0, 0, 0);
    }
    float* ML = (float*)(shm + S_ML); float* OP = (float*)(shm + S_OP) + wid * 4096;
#pragma unroll
    for (int qb = 0; qb < 2; ++qb) { auto rr = __builtin_amdgcn_permlane32_swap(__float_as_uint(lsum[qb]), __float_as_uint(lsum[qb]), false, false);
        const float lt = __uint_as_float(rr[0]) + __uint_as_float(rr[1]);
        if (hi == 0) { ML[wid * 64 + 32 * qb + r32] = mref[qb]; ML[512 + wid * 64 + 32 * qb + r32] = lt; }
#pragma unroll
        for (int d0 = 0; d0 < 2; ++d0)
#pragma unroll
            for (int r = 0; r < 16; ++r) OP[(32 * qb + crow(r, hi)) * 64 + 32 * d0 + r32] = o[qb][d0][r]; }
    __syncthreads();
    { const int q = tid >> 3, ch = tid & 7;
      float mm = ML[q];
#pragma unroll
      for (int w = 1; w < NWAVES; ++w) mm = fmaxf(mm, ML[w * 64 + q]);
      float lt = 0.f; f32x4 a0 = (f32x4){0.f, 0.f, 0.f, 0.f}, a1 = a0;
#pragma unroll
      for (int w = 0; w < NWAVES; ++w) { const float wt = __builtin_amdgcn_exp2f(ML[w * 64 + q] - mm); lt += ML[512 + w * 64 + q] * wt;
          const float* op = (const float*)(shm + S_OP) + w * 4096 + q * 64 + 8 * ch; a0 += *(const f32x4*)op * wt; a1 += *(const f32x4*)(op + 4) * wt; }
      const float il = 1.f / lt; a0 *= il; a1 *= il;
      float ss = ((a0[0] * a0[0] + a0[1] * a0[1]) + (a0[2] * a0[2] + a0[3] * a0[3])) + ((a1[0] * a1[0] + a1[1] * a1[1]) + (a1[2] * a1[2] + a1[3] * a1[3]));
      ss += __shfl_xor(ss, 1); ss += __shfl_xor(ss, 2); ss += __shfl_xor(ss, 4);
      const size_t grow = srow0 + q;
      const u32x4 g = *(const u32x4*)((const bf16_t*)(P.ws + WS_GA) + grow * ATT + h * HD + ch * 8);
      u32x4 w;
      w.x = cvt_pk_bf16(a0[0] * bf2f(g.x & 0xffffu), a0[1] * bf2f(g.x >> 16)); w.y = cvt_pk_bf16(a0[2] * bf2f(g.y & 0xffffu), a0[3] * bf2f(g.y >> 16));
      w.z = cvt_pk_bf16(a1[0] * bf2f(g.z & 0xffffu), a1[1] * bf2f(g.z >> 16)); w.w = cvt_pk_bf16(a1[2] * bf2f(g.w & 0xffffu), a1[3] * bf2f(g.w >> 16));
      *(u32x4*)((bf16_t*)(P.ws + WS_MIX) + grow * DM + h * HD + ch * 8) = w;
      if (ch == 0) ((float*)(P.ws + WS_ASS))[grow * NH + h] = ss; }
    __syncthreads();
}
}
__device__ __forceinline__ void phase_attn(const Ptrs& P, int l, unsigned* qctr, volatile LAS unsigned* slot, char* lds, int tid) {
    for (int i = tid; i < 2048 / 4; i += NWAVES * 64) *(unsigned*)(lds + T0_OFF + 4 * i) = ((const unsigned*)(P.ws + WS_T0))[i];
    const float Mb = (prune_thr(P, l, tid & 63) - 40.f) * 0.5f;
    if (tid == 0) *slot = __hip_atomic_fetch_add(qctr, 1u, __ATOMIC_RELAXED, __HIP_MEMORY_SCOPE_AGENT);
    __syncthreads();
    for (;;) {
        const unsigned u = (unsigned)__builtin_amdgcn_readfirstlane((int)*slot);
        if (u >= (unsigned)(DB * NH + NB * NH * 8)) break;
        if (u < (unsigned)(DB * NH)) { sattn::unit(P, l, u >> 3, u & 7, lds, tid);
            if (tid == 0) *slot = __hip_atomic_fetch_add(qctr, 1u, __ATOMIC_RELAXED, __HIP_MEMORY_SCOPE_AGENT);
            __syncthreads(); continue; }
        const unsigned v = u - DB * NH; int bh, qb;
        if (v < 1024u) { bh = v >> 2; qb = 7 - (v & 3); } else { bh = (v - 1024u) >> 2; qb = 3 - (v & 3); }
        const int T0 = __builtin_amdgcn_readfirstlane((int)*(const unsigned char*)(lds + T0_OFF + bh * 8 + qb));
        attn::attn_unit<8>(P, l, bh >> 3, bh & 7, qb, T0, Mb, qctr, slot, lds, tid);
    }
    __syncthreads();
}

#define XB_TMO      128
#define XB_XCNT(j)  (256  + 64 * (j))
#define XB_XSUB(j)  (1280 + 64 * (j))
#define XB_XGEN(j)  (2304 + 64 * (j))
#define XB_TOP      3328
#define XB_TOPGEN   3392
#define XCD_BAR_WORDS 3456
#define XB_SPIN_CAP (1u << 18)

__device__ __forceinline__ unsigned xb_ld(unsigned* p)              { return __hip_atomic_load(p, __ATOMIC_RELAXED, __HIP_MEMORY_SCOPE_AGENT); }
__device__ __forceinline__ unsigned xb_add(unsigned* p, unsigned v) { return __hip_atomic_fetch_add(p, v, __ATOMIC_RELAXED, __HIP_MEMORY_SCOPE_AGENT); }
__device__ __forceinline__ unsigned xb_xcc_id() { return (unsigned)__builtin_amdgcn_s_getreg((3 << 11) | 20) & 0xFu; }
#define XB_SPIN(cond, bar) do { unsigned _sp = 0; while (cond) { __builtin_amdgcn_s_sleep(1); \
    if ((++_sp & 255u) == 0u) { if (xb_ld(&(bar)[XB_TMO])) break; if (_sp > XB_SPIN_CAP) { atomicAdd(&(bar)[XB_TMO], 1u); break; } } } } while (0)

struct XcdBarrier {
    unsigned* bar; unsigned x;
    volatile LAS unsigned* st;
};

__device__ __forceinline__ XcdBarrier xcd_barrier_post(unsigned* bar, volatile LAS unsigned* st) {
    XcdBarrier b; b.bar = bar; b.x = xb_xcc_id(); b.st = st;
    if (threadIdx.x == 0) (void)xb_add(&bar[XB_XCNT(b.x)], 1u);
    return b;
}
__device__ __forceinline__ void xcd_barrier_complete(unsigned* bar, unsigned x, unsigned& nloc, unsigned& nx) {
    const unsigned G = gridDim.x * gridDim.y * gridDim.z;
    unsigned sum, cnt, mine, sp = 0u;
    for (;;) {
        sum = 0u; cnt = 0u; mine = 0u;
#pragma unroll
        for (unsigned j = 0; j < 16; ++j) { const unsigned c = xb_ld(&bar[XB_XCNT(j)]); sum += c; cnt += (c > 0u) ? 1u : 0u; mine = (j == x) ? c : mine; }
        if (sum == G) break;
        __builtin_amdgcn_s_sleep(1);
        if ((++sp & 255u) == 0u) { if (xb_ld(&bar[XB_TMO])) break; if (sp > XB_SPIN_CAP) { atomicAdd(&bar[XB_TMO], 1u); break; } }
    }
    nloc = mine > 0u ? mine : 1u; nx = cnt > 0u ? cnt : 1u;
}

__device__ __forceinline__ void xcd_barrier(const XcdBarrier& b) {
    asm volatile("s_waitcnt vmcnt(0)" ::: "memory");
    __syncthreads();
    if (threadIdx.x == 0) {
        unsigned* bar = b.bar;
        __builtin_amdgcn_s_waitcnt(0);
        unsigned nloc = b.st[0], nx = b.st[1];
        if (nloc == 0u) { xcd_barrier_complete(bar, b.x, nloc, nx); b.st[0] = nloc; b.st[1] = nx; }
        const unsigned old = xb_add(&bar[XB_XSUB(b.x)], 1u);
        const unsigned gen = old / nloc;
        if (old + 1u == (gen + 1u) * nloc) {
            __builtin_amdgcn_fence(__ATOMIC_RELEASE, "agent");
            asm volatile("s_waitcnt vmcnt(0)" ::: "memory");
            const unsigned og = xb_add(&bar[XB_TOP], 1u);
            const unsigned tg = og / nx;
            if (og + 1u == (tg + 1u) * nx) xb_add(&bar[XB_TOPGEN], 1u);
            else XB_SPIN(xb_ld(&bar[XB_TOPGEN]) == tg, bar);
            __builtin_amdgcn_fence(__ATOMIC_ACQUIRE, "agent");
            xb_add(&bar[XB_XGEN(b.x)], 1u);
            asm volatile("s_waitcnt vmcnt(0)" ::: "memory");
        } else {
            XB_SPIN(xb_ld(&bar[XB_XGEN(b.x)]) == gen, bar);
            __builtin_amdgcn_fence(__ATOMIC_ACQUIRE, "agent");
            asm volatile("s_waitcnt vmcnt(0)" ::: "memory");
        }
    }
    __syncthreads();
}

__device__ __forceinline__ void sample_outproj(const Ptrs& P, int l, int t0, int t1, int rank, int nranks, char* shm, int tid) {
    const int lane = tid & 63, wid = __builtin_amdgcn_readfirstlane(tid >> 6), fr = lane & 15, fq = lane >> 4;
    const bf16_t* W = (const bf16_t*)(P.ws + WS_WOUTT) + (size_t)l * DM * DM; const bf16_t* A = (const bf16_t*)(P.ws + WS_MIX);
    for (int tix = t0 + rank; tix < t1; tix += nranks) {
        const int row0 = NPR + 64 * (tix >> 4), col0 = 64 * (tix & 15), k0 = 128 * wid;
        bf16x8 wf[4][4], af[4][4];
#pragma unroll
        for (int nb = 0; nb < 4; ++nb) { const int c = col0 + 16 * nb + fr, i2 = c & 31, pr = (c & ~31) + 16 * ((i2 >> 2) & 1) + 4 * (i2 >> 3) + (i2 & 3);
#pragma unroll
            for (int ks = 0; ks < 4; ++ks) wf[nb][ks] = *(const bf16x8*)(W + (size_t)pr * DM + k0 + 32 * ks + 8 * fq); }
#pragma unroll
        for (int mb = 0; mb < 4; ++mb)
#pragma unroll
            for (int ks = 0; ks < 4; ++ks) af[mb][ks] = *(const bf16x8*)(A + (size_t)(row0 + 16 * mb + fr) * DM + k0 + 32 * ks + 8 * fq);
        f32x4 acc[4][4];
#pragma unroll
        for (int mb = 0; mb < 4; ++mb)
#pragma unroll
            for (int nb = 0; nb < 4; ++nb) acc[mb][nb] = (f32x4){0.f, 0.f, 0.f, 0.f};
#pragma unroll
        for (int ks = 0; ks < 4; ++ks)
#pragma unroll
            for (int mb = 0; mb < 4; ++mb)
#pragma unroll
                for (int nb = 0; nb < 4; ++nb) acc[mb][nb] = __builtin_amdgcn_mfma_f32_16x16x32_bf16(wf[nb][ks], af[mb][ks], acc[mb][nb], 0, 0, 0);
        float* part = (float*)shm + wid * 4096;
#pragma unroll
        for (int mb = 0; mb < 4; ++mb)
#pragma unroll
            for (int nb = 0; nb < 4; ++nb) *(f32x4*)(part + (16 * mb + fr) * 64 + 16 * nb + 4 * fq) = acc[mb][nb];
        __syncthreads();
        { const int rowl = tid >> 3, cc = (tid & 7) * 8, row = row0 + rowl;
          const float* as = (const float*)(P.ws + WS_ASS) + (size_t)row * 8; float sa = 0.f;
#pragma unroll
          for (int i = 0; i < 8; ++i) sa += as[i];
          const float ra = rsqrtf(sa * (1.f / ATT) + EPS), rc = ((const float*)(P.ws + WS_RC))[row];
          f32x4 s0 = (f32x4){0.f, 0.f, 0.f, 0.f}, s1 = s0, t0 = s0, t1 = s0;
#pragma unroll
          for (int w = 0; w < 4; ++w) { const float* p = (const float*)shm + w * 4096 + rowl * 64 + cc; s0 += *(const f32x4*)p; s1 += *(const f32x4*)(p + 4);
              const float* q = p + 4 * 4096; t0 += *(const f32x4*)q; t1 += *(const f32x4*)(q + 4); }
          bf16_t* xb = (bf16_t*)(P.ws + WS_XB) + (size_t)row * DM + col0 + cc; const u32x4 t = *(const u32x4*)xb;
          const f32x4 o0 = (f32x4){bf2f(t.x & 0xffffu), bf2f(t.x >> 16), bf2f(t.y & 0xffffu), bf2f(t.y >> 16)} + s0 * ra + t0 * rc;
          const f32x4 o1 = (f32x4){bf2f(t.z & 0xffffu), bf2f(t.z >> 16), bf2f(t.w & 0xffffu), bf2f(t.w >> 16)} + s1 * ra + t1 * rc;
          if (l == 0) { u32x4 w; w.x = cvt_pk_bf16(o0[0], o0[1]); w.y = cvt_pk_bf16(o0[2], o0[3]); w.z = cvt_pk_bf16(o1[0], o1[1]); w.w = cvt_pk_bf16(o1[2], o1[3]); *(u32x4*)xb = w; }
          else { float* op = P.out + OFF_YS + (size_t)(row - NPR) * DM + col0 + cc; *(f32x4*)op = o0; *(f32x4*)(op + 4) = o1; } }
        __syncthreads();
    }
}

#ifndef PROBE_NOSAMPLE
#define PROBE_NOSAMPLE 0
#endif
#ifndef PROBE_AT
#define PROBE_AT 0
#define PROBE_EXTRA 0
#endif
enum { PH_PREP = 0, PH_X = 1, PH_A = 2, PH_B = 3, PH_C = 4, PH_PER_LAYER = 4, PH_END = 1 + 2 * PH_PER_LAYER };
struct Args { Ptrs P; int ph_lo, ph_hi, opt_bs, use_cg; };
__global__ void __launch_bounds__(NWAVES * 64, 2) fwd_mega(Args args) {
    extern __shared__ __attribute__((aligned(16))) unsigned char lds_raw[];
    LAS unsigned char* lds = (LAS unsigned char*)lds_raw;
    const Ptrs& P = args.P;
    const int G = gridDim.x, bx = blockIdx.x, vcu = (G % 8 == 0) ? (bx % 8) * (G / 8) + bx / 8 : bx;
    const int grp = (bx >> 5) & 1, rank = (bx & 31) | ((bx >> 6) << 5);
    const int wave0 = __builtin_amdgcn_readfirstlane(threadIdx.x >> 6);
    volatile LAS unsigned* bst = (volatile LAS unsigned*)(lds + BST_OFF);
    if (threadIdx.x < 8) bst[threadIdx.x] = 0u;
    unsigned* barw = (unsigned*)(args.P.ws + WS_CTL);
    __syncthreads();
    XcdBarrier xbar = xcd_barrier_post(barw, bst);
    bool first = true;
    for (int st = args.ph_lo; st < args.ph_hi + PROBE_EXTRA; ++st) {
        const int ph = (PROBE_EXTRA && st > PROBE_AT) ? st - PROBE_EXTRA : st;
        if (ph == 1) continue;
        if (!first) { if (args.use_cg) cooperative_groups::this_grid().sync(); else xcd_barrier(xbar); }
        first = false;
        int lane_id; asm volatile("v_mbcnt_lo_u32_b32 %0, -1, 0\n\tv_mbcnt_hi_u32_b32 %0, -1, %0" : "=v"(lane_id));
        const int tid = wave0 * 64 + lane_id;
        const int lane = tid & 63, wave = wave0;
        const int gw = vcu * NWAVES + wave, NGW = G * NWAVES;
        if (ph == PH_PREP) { phase_prep(P, lds, gw, NGW, lane, wave); __syncthreads(); phase_x<0>(P, gw, NGW, lane); continue; }
        const int l = (ph - 1) / PH_PER_LAYER, k = (ph - 1) % PH_PER_LAYER + 1;
        if (k == PH_X) phase_x<1>(P, gw, NGW, lane);
        else if (k == PH_A) {
            const int srank = ((bx >> 6) - 1) * 32 + (bx & 31);
            if (!grp && bx >= 64) phase_scan(P, l, 0, 192, srank, 96, tid, lds);
            pg8::Gemm g{(const bf16_t*)(P.ws + WS_XB), (const bf16_t*)(P.ws + WS_WINT) + (size_t)l * 4096 * DM, NROW, 4096, DM};
            pg8::StaticOrder S; S.init(NROW, 4096, G, bx);
            { LAS float* glw = (LAS float*)(lds + TAB_OFF + 4096);
              for (int i = tid; i < 2 * HD + 3 * CONV; i += NWAVES * 64) glw[i] = i < HD ? P.q_g[l * HD + i] * C2 : i < 2 * HD ? P.k_g[l * HD + i - HD] : P.conv_w[(size_t)l * 3 * CONV + i - 2 * HD];
              __syncthreads(); }
            EpiA E{P, l, (LAS float*)(lds + TAB_OFF), (const LAS float*)(lds + TAB_OFF + 4096)};
            pg8::gemm_phase<EpiA, pg8::StaticOrder, true, true>(lds, g, S, E, tid);
            if (grp && bx >= 64) phase_scan(P, l, 192, NB * NH + DB * NH, srank, 96, tid, lds);
        } else if (k == PH_B) { phase_fix(P, l, gw, NGW, lane); phase_attn(P, l, barw + 4096 + 64 * (l + 2 * (st - ph)), bst + 4, (char*)lds_raw, tid); }
        else {
            pg8::Gemm g{(const bf16_t*)(P.ws + WS_MIX), (const bf16_t*)(P.ws + WS_WOUTT) + (size_t)l * DM * DM, NROW, DM, DM};
            if (!grp) sample_outproj(P, l, 0, 128, rank, G / 2, (char*)lds_raw, tid);
            pg8::StaticOrder S; S.init(NPR, DM, G, bx);
            EpiC E{P, l, (LAS f32x2*)(lds + TAB_OFF)};
            pg8::gemm_phase<EpiC, pg8::StaticOrder, true, true>(lds, g, S, E, tid);
            if (grp) sample_outproj(P, l, 128, 256, rank, G / 2, (char*)lds_raw, tid);
        }
    }
}

extern "C" void kernel_launch(void* const* d_in, const int* in_sizes, int n_in, void* d_out, int out_size, void* d_ws, size_t ws_size, hipStream_t stream) {
    if (n_in != 15 || (size_t)out_size != OUT_TOTAL || ws_size < WS_END) { fprintf(stderr, "kernel_launch: unexpected sizes n_in %d out %d ws %zu\n", n_in, out_size, ws_size); return; }
    static int grid = 0;
    if (grid == 0) {
        int dev = 0, cus = 0, per_cu = 0;
        (void)hipGetDevice(&dev); (void)hipDeviceGetAttribute(&cus, hipDeviceAttributeMultiprocessorCount, dev);
        (void)hipFuncSetAttribute((const void*)fwd_mega, hipFuncAttributeMaxDynamicSharedMemorySize, LDS_BYTES);
        if (hipOccupancyMaxActiveBlocksPerMultiprocessor(&per_cu, (const void*)fwd_mega, NWAVES * 64, LDS_BYTES) != hipSuccess || per_cu < 1) per_cu = 1;
        grid = cus * per_cu;
        fprintf(stderr, "kernel_launch: grid %d (cus %d x %d per cu)\n", grid, cus, per_cu);
        if (grid != 256) { fprintf(stderr, "kernel_launch: this build's tile orders assume 256 resident workgroups (got %d); nothing launched\n", grid); grid = -1; }
    }
    if (grid < 0) return;
    Args a{};
    a.P.x_prompt = (const float*)d_in[0]; a.P.x_sample = (const float*)d_in[1]; a.P.cache_k = (const float*)d_in[2]; a.P.cache_v = (const float*)d_in[3];
    a.P.cache_logf = (const float*)d_in[4]; a.P.state_conv = (const float*)d_in[5]; a.P.norm_g = (const float*)d_in[6]; a.P.w_in = (const float*)d_in[7];
    a.P.b_f = (const float*)d_in[8]; a.P.q_g = (const float*)d_in[9]; a.P.k_g = (const float*)d_in[10]; a.P.conv_w = (const float*)d_in[11];
    a.P.att_g = (const float*)d_in[12]; a.P.conv_g = (const float*)d_in[13]; a.P.w_out = (const float*)d_in[14];
    a.P.out = (float*)d_out; a.P.ws = (unsigned char*)d_ws;
    a.ph_lo = 0; a.ph_hi = PH_END; a.opt_bs = 1; a.use_cg = 0;
    if (hipMemsetAsync((char*)d_ws + WS_CTL, 0, 65536, stream) != hipSuccess) { fprintf(stderr, "kernel_launch: hipMemsetAsync of the control words failed\n"); return; }
    void* kargs[] = {&a};
    const hipError_t e = hipLaunchCooperativeKernel((const void*)fwd_mega, dim3(grid), dim3(NWAVES * 64), kargs, LDS_BYTES, stream);
    if (e != hipSuccess) fprintf(stderr, "kernel_launch: cooperative launch failed: %s (grid %d)\n", hipGetErrorString(e), grid);
}
```

```cpp
#include <hip/hip_runtime.h>
#include <hip/hip_cooperative_groups.h>
#include <cstdio>
#include <cstdint>

constexpr int DM = 1024, NB = 32, SEQ = 2048, DEPTH = 2, DB = 16, DSEQ = 64, PAST = 2048, NH = 8, HD = 64;
constexpr int ATT = 512, CONV = 512, IN_DIM = 4104;
constexpr int NPR = NB * SEQ, NSR = DB * DSEQ, NROW = NPR + NSR;
constexpr float EPS = 1e-6f;
constexpr float LOG2E = 1.4426950408889634f;
constexpr float C2 = 0.125f * LOG2E;
constexpr int CQ = 0, CK = 512, CV = 1024, CGA = 1536, CF = 2048, CB = 2056, CC = 2568, CH = 3080, CGC = 3592;
constexpr size_t OFF_Y = 0, OFF_YS = 67108864, OFF_KP = 68157440, OFF_VP = 135266304, OFF_LP = 202375168, OFF_CP = 203423744,
                 OFF_KS = 203489280, OFF_VS = 204537856, OFF_LS = 205586432, OFF_CS = 205602816, OUT_TOTAL = 205635584;
constexpr size_t MiB = 1u << 20;
constexpr size_t WS_CTL = 0;
constexpr size_t WS_WINT = 1 * MiB;
constexpr size_t WS_WF = 17 * MiB;
constexpr size_t WS_WOUTT = 18 * MiB;
constexpr size_t WS_XB = 22 * MiB;
constexpr size_t WS_RSTD = 152 * MiB;
constexpr size_t WS_Q = 153 * MiB;
constexpr size_t WS_KB = 218 * MiB;
constexpr size_t WS_VB = 283 * MiB;
constexpr size_t WS_GA = 348 * MiB;
constexpr size_t WS_MIX = 413 * MiB;
constexpr size_t WS_ASS = 543 * MiB;
constexpr size_t WS_CSS = 546 * MiB;
constexpr size_t WS_HALO = 555 * MiB;
constexpr size_t WS_NBP = 706 * MiB;
constexpr size_t WS_NBS = 708 * MiB;
constexpr size_t WS_RC = 710 * MiB;
constexpr size_t WS_T0 = 711 * MiB;
constexpr size_t WS_END = 712 * MiB;

typedef unsigned short bf16_t;
__device__ __forceinline__ unsigned f2bf(float f) { unsigned u = __builtin_bit_cast(unsigned, f); return (u + 0x7fffu + ((u >> 16) & 1u)) >> 16; }
__device__ __forceinline__ float bf2f(unsigned h) { return __builtin_bit_cast(float, h << 16); }

struct Ptrs {
    const float *x_prompt, *x_sample, *cache_k, *cache_v, *cache_logf, *state_conv, *norm_g, *w_in, *b_f, *q_g, *k_g, *conv_w, *att_g, *conv_g, *w_out;
    float* out; unsigned char* ws;
};


#define LAS __attribute__((address_space(3)))
#define GAS __attribute__((address_space(1)))
typedef short bf16x8 __attribute__((ext_vector_type(8)));
typedef float f32x4 __attribute__((ext_vector_type(4)));
typedef float f32x2 __attribute__((ext_vector_type(2)));
typedef unsigned u32x4 __attribute__((ext_vector_type(4)));
typedef unsigned u32x2 __attribute__((ext_vector_type(2)));
constexpr int NWAVES = 8;
constexpr int RING_BYTES = 131072, TAB_OFF = 131072, T0_OFF = 147456, BST_OFF = 151296, LDS_BYTES = 151552;
constexpr int NBLK64 = NROW / 64;
constexpr size_t HALO_STRIDE = (size_t)NBLK64 * 2 * CONV;

__device__ __forceinline__ unsigned cvt_pk_bf16(float lo, float hi) { unsigned r; asm volatile("v_cvt_pk_bf16_f32 %0, %1, %2" : "=v"(r) : "v"(lo), "v"(hi)); return r; }
__device__ __forceinline__ float logsig_fast(float x) {
    const float e = __builtin_amdgcn_exp2f(-fabsf(x) * LOG2E);
    const float l1p = e < 0.00390625f ? e * (1.f - e * (0.5f - e * 0.33333334f)) : __builtin_amdgcn_logf(1.f + e) * 0.6931471805599453f;
    return fminf(x, 0.f) - l1p;
}
__device__ __forceinline__ float fast_silu(float x) { return x * __builtin_amdgcn_rcpf(1.f + __builtin_amdgcn_exp2f(-x * LOG2E)); }

namespace pg8 {
constexpr int BM = 256, BK = 64, HALF = 128, HTB = HALF * BK * 2, STAGE_BYTES = 8 * HTB, NXCD = 8, WGM = 8;
__host__ __device__ __forceinline__ int lds_byte(int r, int c) { const int st = (r >> 4) * 2 + (c >> 5), rr = r & 15, cc = c & 31, ob = rr * 64 + cc * 2; return st * 1024 + (ob ^ (((ob >> 9) & 1) << 5)); }
__host__ __device__ __forceinline__ void stage_rc(int b, int& R, int& C) { const int st = b / 1024, sb = b % 1024, swz = sb ^ (((sb >> 9) & 1) << 5); R = (st >> 1) * 16 + swz / 64; C = (st & 1) * 32 + (swz % 64) / 2; }
struct Unit { int pm, pn; };
struct Gemm { const bf16_t* A; const bf16_t* Bt; int M, N, K; };
struct StaticOrder {
    int nM, nN, nwg, G, c;
    __host__ __device__ void init(int M, int N, int G_, int c_) { nM = M / BM; nN = N / BM; nwg = nM * nN; G = G_; c = c_; }
    __host__ __device__ bool next(int i, Unit& u) const {
        const long L = (long)i * G + c; if (L >= nwg) return false;
        int wgid = (int)L; { const int q = nwg / NXCD, r = nwg % NXCD, xcd = wgid % NXCD, off = wgid / NXCD; wgid = (xcd < r ? xcd * (q + 1) : r * (q + 1) + (xcd - r) * q) + off; }
        const int nig = WGM * nN, gid = wgid / nig, fm = gid * WGM, gsz = (nM - fm) < WGM ? (nM - fm) : WGM;
        u.pm = fm + ((wgid % nig) % gsz); u.pn = (wgid % nig) / gsz; return true;
    }
};
template <class Epi, class Sched, bool ALIGN_EPI, bool SP2>
__device__ __forceinline__ void gemm_phase(LAS unsigned char* lds, const Gemm g, const Sched& S, const Epi& E, const int tid) {
    const int wid = __builtin_amdgcn_readfirstlane(tid >> 6), lane = tid & 63, wr = wid >> 2, wc = wid & 3, fr = lane & 15, fq = lane >> 4;
    const int K = g.K, nt = K / BK;
    unsigned voffA[2], voffB[2];
#pragma unroll
    for (int i = 0; i < 2; ++i) { int R, C; stage_rc(tid * 16 + i * 8192, R, C); voffA[i] = (unsigned)(R * K + C) * 2u; voffB[i] = (unsigned)(R * K + C) * 2u; }
    const size_t kstep = (size_t)(BK * 2);
    const size_t hstep = (size_t)HALF * K * 2;
    const size_t tstep = 2 * hstep;
    const unsigned ldsw = (unsigned)wid * 1024u;
    const int aoff = lds_byte(wr * 64 + fr, fq * 8), boff = lds_byte(wc * 32 + fr, fq * 8);
#define PG8_SA(b, h) (((b) * 2 + (h)) * HTB)
#define PG8_SB(b, h) ((4 + (b) * 2 + (h)) * HTB)
#define PG8_STAGE(bufoff, gbase, voff) do { _Pragma("unroll") for (int _i = 0; _i < 2; ++_i) \
        __builtin_amdgcn_global_load_lds((const unsigned*)((const char*)(gbase) + (voff)[_i]), (LAS unsigned*)(lds + (bufoff) + ldsw + _i * 8192), 16, 0, 0); } while (0)
#define PG8_LDA(dst, b, h) do { _Pragma("unroll") for (int m = 0; m < 4; ++m) _Pragma("unroll") for (int k = 0; k < 2; ++k) dst[m][k] = *(const LAS bf16x8*)(lds + PG8_SA(b, h) + aoff + m * 2048 + k * 1024); } while (0)
#define PG8_LDB(dst, b, h) do { _Pragma("unroll") for (int n = 0; n < 2; ++n) _Pragma("unroll") for (int k = 0; k < 2; ++k) dst[n][k] = *(const LAS bf16x8*)(lds + PG8_SB(b, h) + boff + n * 2048 + k * 1024); } while (0)
#define PG8_MMA(ai, bj, At, Bt) do { __builtin_amdgcn_s_setprio(1); _Pragma("unroll") for (int m = 0; m < 4; ++m) _Pragma("unroll") for (int n = 0; n < 2; ++n) _Pragma("unroll") for (int k = 0; k < 2; ++k) \
        acc[ai][bj][m][n] = __builtin_amdgcn_mfma_f32_16x16x32_bf16(Bt[n][k], At[m][k], acc[ai][bj][m][n], 0, 0, 0); __builtin_amdgcn_s_setprio(0); } while (0)
#define PG8_WAIT_V(n) asm volatile("s_waitcnt vmcnt(" #n ")" ::: "memory")
#define PG8_WAIT_L(n) asm volatile("s_waitcnt lgkmcnt(" #n ")" ::: "memory")
#define PG8_BAR __builtin_amdgcn_s_barrier()
#define PG8_SCHED __builtin_amdgcn_sched_barrier(0)
    Unit cur, nxt; int ui = 0;
    if (!S.next(0, cur)) return;
    f32x4 acc[2][2][4][2];
#pragma unroll
    for (int a = 0; a < 2; ++a)
#pragma unroll
        for (int b = 0; b < 2; ++b)
#pragma unroll
            for (int m = 0; m < 4; ++m)
#pragma unroll
                for (int n = 0; n < 2; ++n) acc[a][b][m][n] = (f32x4){0.f, 0.f, 0.f, 0.f};
    bf16x8 At[4][2], B0[2][2], B1[2][2];
    const char* cA = (const char*)g.A + (size_t)cur.pm * tstep; const char* cB = (const char*)g.Bt + (size_t)cur.pn * tstep;
    typename Epi::PrepRegs pr;
    if constexpr (Epi::PREP) { E.prep_load(cur, tid, pr); E.prep_store(0, tid, pr); asm volatile("" ::: "memory"); }
    if constexpr (SP2) {
        PG8_STAGE(PG8_SB(0, 0), cB, voffB); PG8_STAGE(PG8_SB(0, 1), cB + hstep, voffB); PG8_STAGE(PG8_SA(0, 0), cA, voffA); PG8_STAGE(PG8_SA(0, 1), cA + hstep, voffA);
        if (wr == 1) PG8_BAR;
        PG8_WAIT_V(2); PG8_BAR;
        PG8_STAGE(PG8_SB(1, 0), cB + kstep, voffB); PG8_STAGE(PG8_SA(1, 0), cA + kstep, voffA); PG8_STAGE(PG8_SB(1, 1), cB + hstep + kstep, voffB);
        PG8_WAIT_V(6); PG8_BAR;
    } else {
        PG8_STAGE(PG8_SB(0, 0), cB, voffB); PG8_STAGE(PG8_SA(0, 0), cA, voffA); PG8_STAGE(PG8_SB(0, 1), cB + hstep, voffB); PG8_STAGE(PG8_SA(0, 1), cA + hstep, voffA);
        if (wr == 1) PG8_BAR;
        PG8_WAIT_V(4); PG8_BAR;
        PG8_STAGE(PG8_SB(1, 0), cB + kstep, voffB); PG8_STAGE(PG8_SA(1, 0), cA + kstep, voffA); PG8_STAGE(PG8_SB(1, 1), cB + hstep + kstep, voffB);
        PG8_WAIT_V(6); PG8_BAR;
    }
    for (;;) {
        const bool has_next = S.next(ui + 1, nxt);
        const char* nA = has_next ? (const char*)g.A + (size_t)nxt.pm * tstep : cA; const char* nB = has_next ? (const char*)g.Bt + (size_t)nxt.pn * tstep : cB;
        for (int t = 0; t < nt; t += 2) {
            const bool last = (t == nt - 2);
            const char* a1 = cA + (size_t)(t + 1) * kstep;
            const char* a2 = last ? nA : cA + (size_t)(t + 2) * kstep; const char* b2 = last ? nB : cB + (size_t)(t + 2) * kstep;
            const char* a3 = a2 + kstep; const char* b3 = b2 + kstep;
            if constexpr (SP2) {
            PG8_LDB(B0, 0, 0); PG8_LDB(B1, 0, 1); PG8_SCHED; PG8_LDA(At, 0, 0); PG8_STAGE(PG8_SA(1, 1), a1 + hstep, voffA);
            PG8_WAIT_V(8); PG8_WAIT_L(0); PG8_BAR; PG8_MMA(0, 0, At, B0); PG8_MMA(0, 1, At, B1); PG8_BAR; PG8_SCHED;
            PG8_LDA(At, 0, 1); PG8_STAGE(PG8_SB(0, 0), b2, voffB); PG8_STAGE(PG8_SB(0, 1), b2 + hstep, voffB); PG8_STAGE(PG8_SA(0, 0), a2, voffA);
            PG8_WAIT_V(8); PG8_WAIT_L(0); PG8_BAR; PG8_MMA(1, 0, At, B0); PG8_MMA(1, 1, At, B1); PG8_BAR; PG8_SCHED;
            PG8_LDB(B0, 1, 0); PG8_LDB(B1, 1, 1); PG8_SCHED; PG8_LDA(At, 1, 0); PG8_STAGE(PG8_SA(0, 1), a2 + hstep, voffA);
            PG8_WAIT_V(8); PG8_WAIT_L(0); PG8_BAR; PG8_MMA(0, 0, At, B0); PG8_MMA(0, 1, At, B1); PG8_BAR; PG8_SCHED;
            PG8_LDA(At, 1, 1); PG8_STAGE(PG8_SB(1, 0), b3, voffB); PG8_STAGE(PG8_SB(1, 1), b3 + hstep, voffB); PG8_STAGE(PG8_SA(1, 0), a3, voffA);
            PG8_WAIT_V(8); PG8_WAIT_L(0); PG8_BAR; PG8_MMA(1, 0, At, B0); PG8_MMA(1, 1, At, B1); PG8_BAR; PG8_SCHED;
            } else {
            PG8_LDB(B0, 0, 0); PG8_SCHED; PG8_LDA(At, 0, 0); PG8_STAGE(PG8_SA(1, 1), a1 + hstep, voffA);
            PG8_WAIT_L(8); PG8_BAR; PG8_WAIT_L(0); PG8_MMA(0, 0, At, B0); PG8_BAR; PG8_SCHED;
            PG8_LDB(B1, 0, 1); PG8_STAGE(PG8_SB(0, 0), b2, voffB);
            PG8_BAR; PG8_WAIT_L(0); PG8_MMA(0, 1, At, B1); PG8_BAR;
            PG8_LDA(At, 0, 1); PG8_STAGE(PG8_SA(0, 0), a2, voffA);
            PG8_BAR; PG8_WAIT_L(0); PG8_MMA(1, 0, At, B0); PG8_BAR; PG8_SCHED;
            PG8_STAGE(PG8_SB(0, 1), b2 + hstep, voffB);
            PG8_WAIT_V(6); PG8_BAR; PG8_MMA(1, 1, At, B1); PG8_BAR;
            PG8_LDB(B0, 1, 0); PG8_SCHED; PG8_LDA(At, 1, 0); PG8_STAGE(PG8_SA(0, 1), a2 + hstep, voffA);
            PG8_WAIT_L(8); PG8_BAR; PG8_WAIT_L(0); PG8_MMA(0, 0, At, B0); PG8_BAR; PG8_SCHED;
            PG8_LDB(B1, 1, 1); PG8_STAGE(PG8_SB(1, 0), b3, voffB);
            PG8_BAR; PG8_WAIT_L(0); PG8_MMA(0, 1, At, B1); PG8_BAR;
            PG8_LDA(At, 1, 1); PG8_STAGE(PG8_SA(1, 0), a3, voffA);
            PG8_BAR; PG8_WAIT_L(0); PG8_MMA(1, 0, At, B0); PG8_BAR; PG8_SCHED;
            PG8_STAGE(PG8_SB(1, 1), b3 + hstep, voffB);
            PG8_WAIT_V(6); PG8_BAR; PG8_MMA(1, 1, At, B1); PG8_BAR;
            }
            if constexpr (Epi::MID) { if (t == nt / 2 - 2) E.mid(acc, ui & 1, wr, fr); }
        }
        if constexpr (ALIGN_EPI) { if (wr == 0) PG8_BAR; }
        if constexpr (Epi::PREP) { if (has_next) E.prep_load(nxt, tid, pr); }
        E(acc, cur, wr, wc, fr, fq, ui & 1);
        if constexpr (Epi::PREP) { if (has_next) { E.prep_store((ui + 1) & 1, tid, pr); asm volatile("" ::: "memory"); } }
        if (!has_next) break;
#pragma unroll
        for (int a = 0; a < 2; ++a)
#pragma unroll
            for (int b = 0; b < 2; ++b)
#pragma unroll
                for (int m = 0; m < 4; ++m)
#pragma unroll
                    for (int n = 0; n < 2; ++n) acc[a][b][m][n] = (f32x4){0.f, 0.f, 0.f, 0.f};
        cur = nxt; cA = nA; cB = nB; ++ui;
        if constexpr (ALIGN_EPI) { if (wr == 1) PG8_BAR; }
    }
    PG8_WAIT_V(0);
    if constexpr (!ALIGN_EPI) { if (wr == 0) PG8_BAR; }
    PG8_BAR;
#undef PG8_SA
#undef PG8_SB
#undef PG8_STAGE
#undef PG8_LDA
#undef PG8_LDB
#undef PG8_MMA
#undef PG8_WAIT_V
#undef PG8_WAIT_L
#undef PG8_BAR
#undef PG8_SCHED
}
}

__device__ __forceinline__ float rows4_sum(float x) {
    auto a = __builtin_amdgcn_permlane16_swap(__float_as_uint(x), __float_as_uint(x), false, false); const float y = __uint_as_float(a[0]) + __uint_as_float(a[1]);
    auto b = __builtin_amdgcn_permlane32_swap(__float_as_uint(y), __float_as_uint(y), false, false); return __uint_as_float(b[0]) + __uint_as_float(b[1]);
}
struct EpiA {
    static constexpr bool MID = false, PREP = true; struct PrepRegs { float rs; };
    const Ptrs& P; int l; LAS float* tab; const LAS float* gl;
    __device__ __forceinline__ void prep_load(const pg8::Unit& u, int tid, PrepRegs& r) const { if (tid < 256) r.rs = ((const float*)(P.ws + WS_RSTD))[u.pm * 256 + tid]; }
    __device__ __forceinline__ void prep_store(int buf, int tid, const PrepRegs& r) const { if (tid < 256) tab[buf * 256 + tid] = r.rs; }
    template <int KIND>
    __device__ __forceinline__ void attn_tile(const f32x4 (&acc)[2][2][4][2], const pg8::Unit& u, int wr, int wc, int fr, int fq, int buf) const {
        const bool smp = u.pm >= NPR / 256;
        const int head = 4 * (u.pn & 1) + wc, row0 = u.pm * 256 + wr * 64;
        const LAS float* rst = tab + buf * 256 + wr * 64 + fr;
        const unsigned vrow = (unsigned)(fr * (ATT * 2) + fq * 16);
        const unsigned vf32 = (unsigned)(fr * (ATT * 4) + fq * 16);
        const unsigned vimg = smp ? vrow : (KIND == 1 ? (unsigned)(fq * 1024 + fr * 16) : (unsigned)(fr * 64 + fq * 16));
        unsigned char* const rowmaj = P.ws + (KIND == 0 ? WS_Q : KIND == 1 ? WS_KB : KIND == 2 ? WS_VB : WS_GA) + ((size_t)row0 * ATT + head * 64) * 2;
        unsigned char* const img = P.ws + (KIND == 1 ? WS_KB : WS_VB) + ((size_t)((u.pm >> 3) * NH + head) * 32 + ((u.pm & 7) * 4 + wr)) * 8192;
        float* const of32 = (smp ? P.out + (KIND == 1 ? OFF_KS : OFF_VS) + ((size_t)l * NSR + (row0 - NPR)) * ATT : P.out + (KIND == 1 ? OFF_KP : OFF_VP) + ((size_t)l * NPR + row0) * ATT) + head * 64;
        f32x4 gg[2][2];
        if constexpr (KIND <= 1) { const LAS float* gsrc = gl + (KIND == 0 ? 0 : HD) + 8 * fq;
#pragma unroll
            for (int bj = 0; bj < 2; ++bj)
#pragma unroll
                for (int n = 0; n < 2; ++n) gg[bj][n] = *(const LAS f32x4*)(gsrc + 32 * bj + 4 * n); }
#pragma unroll
        for (int ai = 0; ai < 2; ++ai)
#pragma unroll
            for (int m = 0; m < 4; ++m) {
                const int rr = 128 * ai + 16 * m; const float rs = rst[rr];
                float sc = rs;
                if constexpr (KIND <= 1) {
                    float s0 = 0.f, s1 = 0.f;
#pragma unroll
                    for (int bj = 0; bj < 2; ++bj)
#pragma unroll
                        for (int j = 0; j < 4; ++j) { s0 = fmaf(acc[ai][bj][m][0][j], acc[ai][bj][m][0][j], s0); s1 = fmaf(acc[ai][bj][m][1][j], acc[ai][bj][m][1][j], s1); }
                    const float ss = rows4_sum(s0 + s1);
                    sc = rs * rsqrtf(ss * (rs * rs) * (1.f / HD) + EPS);
                }
#pragma unroll
                for (int bj = 0; bj < 2; ++bj) {
                    f32x4 a, b;
#pragma unroll
                    for (int j = 0; j < 4; ++j) {
                        if constexpr (KIND <= 1) { a[j] = acc[ai][bj][m][0][j] * sc * gg[bj][0][j]; b[j] = acc[ai][bj][m][1][j] * sc * gg[bj][1][j]; }
                        else if constexpr (KIND == 2) { a[j] = acc[ai][bj][m][0][j] * sc; b[j] = acc[ai][bj][m][1][j] * sc; }
                        else { a[j] = fast_silu(acc[ai][bj][m][0][j] * sc); b[j] = fast_silu(acc[ai][bj][m][1][j] * sc); } }
                    if constexpr (KIND == 1 || KIND == 2) if (smp) { float* o = of32 + (size_t)rr * ATT + 32 * bj;
                        f32x4 a2, b2;
#pragma unroll
                        for (int j = 0; j < 4; ++j) {
                            auto s1 = __builtin_amdgcn_permlane16_swap(__float_as_uint(a[j]), __float_as_uint(b[j]), false, false);
                            auto s2 = __builtin_amdgcn_permlane32_swap(s1[0], s1[1], false, false);
                            a2[j] = __uint_as_float(s2[0]); b2[j] = __uint_as_float(s2[1]); }
                        __builtin_nontemporal_store(a2, (f32x4*)((unsigned char*)o + vf32)); __builtin_nontemporal_store(b2, (f32x4*)((unsigned char*)o + 64 + vf32)); }
                    u32x4 w; w.x = cvt_pk_bf16(a[0], a[1]); w.y = cvt_pk_bf16(a[2], a[3]); w.z = cvt_pk_bf16(b[0], b[1]); w.w = cvt_pk_bf16(b[2], b[3]);
                    if constexpr (KIND == 0 || KIND == 3) *(u32x4*)(rowmaj + (size_t)rr * (ATT * 2) + 64 * bj + vrow) = w;
                    else { unsigned char* d = smp ? rowmaj + (size_t)rr * (ATT * 2) + 64 * bj
                                                  : img + (size_t)(2 * ai) * 8192 + bj * 4096 + m * (KIND == 1 ? 256 : 1024);
                        *(u32x4*)(d + vimg) = w; }
                }
            }
    }
    __device__ __forceinline__ void operator()(const f32x4 (&acc)[2][2][4][2], const pg8::Unit& u, int wr, int wc, int fr, int fq, int buf) const {
        const int lane = fq * 16 + fr;
        const LAS float* rstd = tab + buf * 256 - u.pm * 256;
        const int rbase = u.pm * 256 + wr * 64 + fr;
        const bool smp = u.pm >= NPR / 256;
        if (u.pn < 8) {
            const int kp = u.pn >> 1;
            if (kp == 0) attn_tile<0>(acc, u, wr, wc, fr, fq, buf); else if (kp == 1) attn_tile<1>(acc, u, wr, wc, fr, fq, buf);
            else if (kp == 2) attn_tile<3>(acc, u, wr, wc, fr, fq, buf); else attn_tile<2>(acc, u, wr, wc, fr, fq, buf);
        } else {
            const int g = u.pn - 8, ch0 = 64 * g + 16 * wc + 4 * fq;
            const LAS float* cw = gl + 2 * HD + ch0;
            const f32x4 w0 = *(const LAS f32x4*)cw, w1 = *(const LAS f32x4*)(cw + CONV), w2 = *(const LAS f32x4*)(cw + 2 * CONV);
            float* halo = (float*)(P.ws + WS_HALO);
            const int row0 = u.pm * 256 + wr * 64;
            const LAS float* rst = tab + buf * 256 + wr * 64 + fr;
            unsigned char* const mixb = P.ws + WS_MIX + ((size_t)row0 * DM + 512 + 64 * g + 16 * wc) * 2;
            float* const cssb = (float*)(P.ws + WS_CSS) + (size_t)row0 * 32 + 4 * g + wc;
            const unsigned vmix = (unsigned)(fr * (DM * 2) + fq * 8), vcss = (unsigned)(fr * 128);
#pragma unroll
            for (int ai = 0; ai < 2; ++ai) {
                const int kb = 4 * u.pm + 2 * ai + wr;
                f32x4 p1 = (f32x4){0.f, 0.f, 0.f, 0.f}, p2 = p1; float zsv[4];
#pragma unroll
                for (int m = 0; m < 4; ++m) {
                    const int rr = 128 * ai + 16 * m; const float rs = rst[rr];
                    f32x4 Bv, uu, Gv, r1, r2, sg;
#pragma unroll
                    for (int j = 0; j < 4; ++j) { Bv[j] = acc[ai][0][m][0][j] * rs; uu[j] = (acc[ai][0][m][1][j] * rs) * (acc[ai][1][m][0][j] * rs); Gv[j] = acc[ai][1][m][1][j] * rs; }
#pragma unroll
                    for (int j = 0; j < 4; ++j) {
                        asm("s_nop 1\n\tv_mov_b32_dpp %0, %2 row_ror:1 row_mask:0xf bank_mask:0xf\n\tv_mov_b32_dpp %1, %2 row_ror:2 row_mask:0xf bank_mask:0xf" : "=&v"(r1[j]), "=&v"(r2[j]) : "v"(uu[j]));
                        sg[j] = fast_silu(Gv[j]); }
                    f32x4 z; float zs = 0.f;
#pragma unroll
                    for (int j = 0; j < 4; ++j) { const float um1 = fr >= 1 ? r1[j] : p1[j], um2 = fr >= 2 ? r2[j] : p2[j];
                        z[j] = Bv[j] * fmaf(w0[j], um2, fmaf(w1[j], um1, w2[j] * uu[j])); zs = fmaf(z[j], z[j], zs); }
                    zsv[m] = zs;
                    const bool skip = (m == 0) && (fr < 2);
                    if (!skip) { u32x2 w; w.x = cvt_pk_bf16(z[0] * sg[0], z[1] * sg[1]); w.y = cvt_pk_bf16(z[2] * sg[2], z[3] * sg[3]);
                        *(u32x2*)(mixb + (size_t)rr * (DM * 2) + vmix) = w; }
                    else { float* hp = halo + ((size_t)kb * 2 + fr) * CONV + ch0;
                        *(f32x4*)(hp + HALO_STRIDE) = Bv; *(f32x4*)(hp + 2 * HALO_STRIDE) = uu; *(f32x4*)(hp + 3 * HALO_STRIDE) = sg; }
                    if (m == 3 && fr >= 14) {
                        *(f32x4*)(halo + ((size_t)kb * 2 + (fr - 14)) * CONV + ch0) = uu;
                        if (smp) *(f32x4*)(P.out + OFF_CS + (((size_t)l * DB + (kb - NPR / 64)) * 2 + (fr - 14)) * CONV + ch0) = uu;
                        else if ((kb & 31) == 31) *(f32x4*)(P.out + OFF_CP + (((size_t)l * NB + (kb >> 5)) * 2 + (fr - 14)) * CONV + ch0) = uu;
                    }
                    p1 = r1; p2 = r2;
                }
#pragma unroll
                for (int m = 0; m < 4; ++m) zsv[m] = rows4_sum(zsv[m]);
#pragma unroll
                for (int m = 0; m < 4; ++m) if (fq == 0 && !(m == 0 && fr < 2)) *(float*)((unsigned char*)(cssb + (size_t)(128 * ai + 16 * m) * 32) + vcss) = zsv[m];
            }
        }
    }
};

struct EpiC {
    static constexpr bool MID = true, PREP = true;
    const Ptrs& P; int l; LAS f32x2* tab;
    struct PrepRegs { f32x4 a0, a1; float rc; };
    __device__ __forceinline__ void prep_load(const pg8::Unit& u, int tid, PrepRegs& r) const {
        if (tid < 256) { const int row = u.pm * 256 + tid; const f32x4* a = (const f32x4*)((const float*)(P.ws + WS_ASS) + (size_t)row * 8);
            r.a0 = a[0]; r.a1 = a[1]; r.rc = ((const float*)(P.ws + WS_RC))[row]; }
    }
    __device__ __forceinline__ void prep_store(int buf, int tid, const PrepRegs& r) const {
        if (tid < 256) { const f32x4 sa = r.a0 + r.a1; const float ra = rsqrtf(((sa[0] + sa[1]) + (sa[2] + sa[3])) * (1.f / ATT) + EPS);
            tab[buf * 256 + tid] = (f32x2){ra / r.rc, r.rc}; }
    }
    __device__ __forceinline__ void mid(f32x4 (&acc)[2][2][4][2], int buf, int wr, int fr) const {
        const unsigned a = (unsigned)(size_t)(tab + buf * 256 + wr * 64 + fr);
        float q0, q1, q2, q3, q4, q5, q6, q7;
        asm volatile("ds_read_b32 %0, %8\n\tds_read_b32 %1, %8 offset:128\n\tds_read_b32 %2, %8 offset:256\n\tds_read_b32 %3, %8 offset:384\n\t"
                     "ds_read_b32 %4, %8 offset:1024\n\tds_read_b32 %5, %8 offset:1152\n\tds_read_b32 %6, %8 offset:1280\n\tds_read_b32 %7, %8 offset:1408\n\ts_waitcnt lgkmcnt(0)"
                     : "=&v"(q0), "=&v"(q1), "=&v"(q2), "=&v"(q3), "=&v"(q4), "=&v"(q5), "=&v"(q6), "=&v"(q7) : "v"(a) : "memory");
        const float q[2][4] = {{q0, q1, q2, q3}, {q4, q5, q6, q7}};
#pragma unroll
        for (int ai = 0; ai < 2; ++ai)
#pragma unroll
            for (int m = 0; m < 4; ++m)
#pragma unroll
                for (int bj = 0; bj < 2; ++bj)
#pragma unroll
                    for (int n = 0; n < 2; ++n) acc[ai][bj][m][n] *= q[ai][m];
    }
    __device__ __forceinline__ void operator()(const f32x4 (&acc)[2][2][4][2], const pg8::Unit& u, int wr, int wc, int fr, int fq, int buf) const {
        const bool smp = u.pm >= NPR / 256; const int col0 = u.pn * 256 + wc * 32 + 8 * fq;
        bf16_t* xb = (bf16_t*)(P.ws + WS_XB);
        float* obase = (smp ? P.out + OFF_YS : P.out + OFF_Y);
        const int r0 = u.pm * 256 + wr * 64 + fr;
#pragma unroll
        for (int ai = 0; ai < 2; ++ai) {
            u32x4 x[4][2];
#pragma unroll
            for (int m = 0; m < 4; ++m) { const int r = r0 + ai * 128 + m * 16;
#pragma unroll
                for (int bj = 0; bj < 2; ++bj) x[m][bj] = *(const u32x4*)(xb + (size_t)r * DM + col0 + bj * 128); }
#pragma unroll
            for (int m = 0; m < 4; ++m) { const int rl = ai * 128 + wr * 64 + m * 16 + fr, r = u.pm * 256 + rl; const float rc = tab[buf * 256 + rl].y;
                const size_t off = (smp ? (size_t)(r - NPR) : (size_t)r) * DM + col0;
#pragma unroll
                for (int bj = 0; bj < 2; ++bj) { const u32x4 t = x[m][bj];
                    const f32x4 o0 = (f32x4){bf2f(t.x & 0xffffu), bf2f(t.x >> 16), bf2f(t.y & 0xffffu), bf2f(t.y >> 16)} + acc[ai][bj][m][0] * rc;
                    const f32x4 o1 = (f32x4){bf2f(t.z & 0xffffu), bf2f(t.z >> 16), bf2f(t.w & 0xffffu), bf2f(t.w >> 16)} + acc[ai][bj][m][1] * rc;
                    if (l == 0) { u32x4 w; w.x = cvt_pk_bf16(o0[0], o0[1]); w.y = cvt_pk_bf16(o0[2], o0[3]); w.z = cvt_pk_bf16(o1[0], o1[1]); w.w = cvt_pk_bf16(o1[2], o1[3]);
                        *(u32x4*)(xb + (size_t)r * DM + col0 + bj * 128) = w; }
                    else { __builtin_nontemporal_store(o0, (f32x4*)(obase + off + bj * 128)); __builtin_nontemporal_store(o1, (f32x4*)(obase + off + bj * 128 + 4)); } } }
            asm volatile("" ::: "memory");
        }
    }
};

__device__ __forceinline__ int destrow(int s) {
    if (s < 2048) { const int seg = s >> 9, c = s & 511, h = c >> 6, d = c & 63, i2 = d & 31;
        const int sp = seg == 2 ? 3 : seg == 3 ? 2 : seg;
        return 256 * (2 * sp + (h >> 2)) + 128 * (d >> 5) + 32 * (h & 3) + 16 * ((i2 >> 2) & 1) + 4 * (i2 >> 3) + (i2 & 3); }
    const int c2 = s - CB, kind = c2 >> 9, ch = c2 & 511;
    return 256 * (8 + (ch >> 6)) + 128 * (kind >> 1) + 32 * ((ch >> 4) & 3) + 16 * (kind & 1) + 4 * ((ch >> 2) & 3) + (ch & 3);
}
template <bool WIN>
__device__ __forceinline__ void prep_item(const float* W, int ldw, int s0, int k0, const float* kscale, bf16_t* WT, LAS float* scr, int lane) {
    float wv[32];
#pragma unroll
    for (int i = 0; i < 32; ++i) { const int kk = 2 * i + (lane >> 5); wv[i] = W[(size_t)(k0 + kk) * ldw + s0 + (lane & 31)]; }
    const float ks0 = kscale[k0 + lane];
#pragma unroll
    for (int i = 0; i < 32; ++i) { const int kk = 2 * i + (lane >> 5); scr[kk * 33 + (lane & 31)] = wv[i] * __shfl(ks0, kk); }
    asm volatile("s_waitcnt lgkmcnt(0)" ::: "memory");
    const int c = lane & 7;
#pragma unroll
    for (int j = 0; j < 4; ++j) { const int n = (lane >> 3) + 8 * j; const LAS float* s = scr + (8 * c) * 33 + n;
        u32x4 o; o.x = cvt_pk_bf16(s[0 * 33], s[1 * 33]); o.y = cvt_pk_bf16(s[2 * 33], s[3 * 33]); o.z = cvt_pk_bf16(s[4 * 33], s[5 * 33]); o.w = cvt_pk_bf16(s[6 * 33], s[7 * 33]);
        const int cc = s0 + n, i2 = cc & 31;
        const int dr = WIN ? destrow(cc) : ((cc & ~31) + 16 * ((i2 >> 2) & 1) + 4 * (i2 >> 3) + (i2 & 3));
        *(u32x4*)(WT + (size_t)dr * DM + k0 + 8 * c) = o; }
    asm volatile("s_waitcnt lgkmcnt(0)" ::: "memory");
}
__device__ __forceinline__ void phase_prep(const Ptrs& P, LAS unsigned char* lds, int gw, int NGW, int lane, int wave) {
    LAS float* scr = (LAS float*)(lds + wave * 16384);
    constexpr int I_IN = 16 * 128, I_OUT = 16 * 32, NITEMS = 2 * (I_IN + I_OUT);
    for (int it = gw; it < NITEMS; it += NGW) {
        const int l = it / (I_IN + I_OUT); int r = it % (I_IN + I_OUT);
        if (r < I_IN) { const int kb = r / 128, sb = r % 128, s0 = sb < 64 ? 32 * sb : CB + 32 * (sb - 64);
            prep_item<true>(P.w_in + (size_t)l * DM * IN_DIM, IN_DIM, s0, 64 * kb, P.norm_g + l * DM, (bf16_t*)(P.ws + WS_WINT) + (size_t)l * 4096 * DM, scr, lane); }
        else { r -= I_IN; const int kb = r / 32, nb = r % 32; const int k0 = 64 * kb;
            const float* gain = k0 < 512 ? P.att_g + l * ATT : P.conv_g + l * CONV - 512;
            prep_item<false>(P.w_out + (size_t)l * DM * DM, DM, 32 * nb, k0, gain, (bf16_t*)(P.ws + WS_WOUTT) + (size_t)l * DM * DM, scr, lane); }
    }
    for (int i = gw * 64 + lane; i < 2 * 8 * DM; i += NGW * 64) { const int l = i / (8 * DM), h = (i / DM) & 7, k = i % DM;
        ((float*)(P.ws + WS_WF))[i] = P.w_in[((size_t)l * DM + k) * IN_DIM + CF + h] * P.norm_g[l * DM + k]; }
}

template <int L> struct XRaw { typedef f32x4 T; };
template <> struct XRaw<1> { typedef u32x2 T; };
template <int L>
__device__ __forceinline__ void phase_x(const Ptrs& P, int gw, int NGW, int lane) {
    constexpr int l = L; typedef typename XRaw<L>::T RT;
    const float* wf = (const float*)(P.ws + WS_WF) + (size_t)l * 8 * DM;
    f32x4 w[8][4];
    if constexpr (L == 0) {
#pragma unroll
        for (int j = 0; j < 4; ++j)
#pragma unroll
            for (int c = 0; c < 4; ++c) { const int k = 256 * j + 4 * lane + c; const float gk = P.norm_g[k];
                const f32x4 a = *(const f32x4*)(P.w_in + (size_t)k * IN_DIM + CF), b = *(const f32x4*)(P.w_in + (size_t)k * IN_DIM + CF + 4);
                w[0][j][c] = a[0] * gk; w[1][j][c] = a[1] * gk; w[2][j][c] = a[2] * gk; w[3][j][c] = a[3] * gk;
                w[4][j][c] = b[0] * gk; w[5][j][c] = b[1] * gk; w[6][j][c] = b[2] * gk; w[7][j][c] = b[3] * gk; }
    } else {
#pragma unroll
        for (int h = 0; h < 8; ++h)
#pragma unroll
            for (int j = 0; j < 4; ++j) w[h][j] = *(const f32x4*)(wf + h * DM + 256 * j + 4 * lane);
    }
    const float bfv = P.b_f[l * NH + (lane >> 3)];
    const bool b5 = (lane & 32) != 0, b4 = (lane & 16) != 0, b3 = (lane & 8) != 0;
#define XLOAD(dst, r0_) do { _Pragma("unroll") for (int rr = 0; rr < 2; ++rr) { int row = (r0_) + rr * NGW; if (row >= NROW) row = gw; \
        if constexpr (L == 0) { const float* xin = row < NPR ? P.x_prompt + (size_t)row * DM : P.x_sample + (size_t)(row - NPR) * DM; \
            _Pragma("unroll") for (int j = 0; j < 4; ++j) dst[rr][j] = *(const f32x4*)(xin + 256 * j + 4 * lane); } \
        else { const u32x2* xb = (const u32x2*)((const bf16_t*)(P.ws + WS_XB) + (size_t)row * DM); \
            _Pragma("unroll") for (int j = 0; j < 4; ++j) dst[rr][j] = xb[64 * j + lane]; } } } while (0)
    RT cur[2][4], nxt[2][4];
    XLOAD(cur, gw);
    for (int row0 = gw; row0 < NROW; row0 += 2 * NGW) {
        XLOAD(nxt, row0 + 2 * NGW);
        f32x4 v[2][4]; float ss[2]; f32x4 flo[2], fhi[2];
#pragma unroll
        for (int rr = 0; rr < 2; ++rr) {
#pragma unroll
            for (int j = 0; j < 4; ++j) { if constexpr (L == 0) v[rr][j] = cur[rr][j];
                else { const u32x2 t = cur[rr][j]; v[rr][j] = (f32x4){bf2f(t.x & 0xffffu), __builtin_bit_cast(float, t.x & 0xffff0000u), bf2f(t.y & 0xffffu), __builtin_bit_cast(float, t.y & 0xffff0000u)}; } }
            float s_ = 0.f;
#pragma unroll
            for (int j = 0; j < 4; ++j) s_ += (v[rr][j][0] * v[rr][j][0] + v[rr][j][1] * v[rr][j][1]) + (v[rr][j][2] * v[rr][j][2] + v[rr][j][3] * v[rr][j][3]);
            ss[rr] = s_;
#pragma unroll
            for (int h = 0; h < 8; ++h) { f32x4 a = v[rr][0] * w[h][0] + v[rr][1] * w[h][1] + v[rr][2] * w[h][2] + v[rr][3] * w[h][3]; const float d_ = (a[0] + a[1]) + (a[2] + a[3]);
                if (h < 4) flo[rr][h] = d_; else fhi[rr][h - 4] = d_; }
        }
        f32x4 g4[2]; f32x2 g2[2]; float fh[2];
#pragma unroll
        for (int rr = 0; rr < 2; ++rr) {
#pragma unroll
            for (int i = 0; i < 4; ++i) { auto p_ = __builtin_amdgcn_permlane32_swap(__float_as_uint(flo[rr][i]), __float_as_uint(fhi[rr][i]), false, false); g4[rr][i] = __uint_as_float(p_[0]) + __uint_as_float(p_[1]); }
            { auto p_ = __builtin_amdgcn_permlane32_swap(__float_as_uint(ss[rr]), __float_as_uint(ss[rr]), false, false); ss[rr] = __uint_as_float(p_[0]) + __uint_as_float(p_[1]); } }
#pragma unroll
        for (int rr = 0; rr < 2; ++rr) {
#pragma unroll
            for (int i = 0; i < 2; ++i) { auto p_ = __builtin_amdgcn_permlane16_swap(__float_as_uint(g4[rr][i]), __float_as_uint(g4[rr][2 + i]), false, false); g2[rr][i] = __uint_as_float(p_[0]) + __uint_as_float(p_[1]); }
            { auto p_ = __builtin_amdgcn_permlane16_swap(__float_as_uint(ss[rr]), __float_as_uint(ss[rr]), false, false); ss[rr] = __uint_as_float(p_[0]) + __uint_as_float(p_[1]); } }
#pragma unroll
        for (int rr = 0; rr < 2; ++rr) { const float x_ = g2[rr][0], y_ = g2[rr][1]; const float snd_ = b3 ? x_ : y_, kp_ = b3 ? y_ : x_; float r_, q_;
            asm("s_nop 1\n\tv_add_f32_dpp %0, %1, %2 row_ror:8 row_mask:0xf bank_mask:0xf" : "=&v"(r_) : "v"(snd_), "v"(kp_)); fh[rr] = r_;
            asm("s_nop 1\n\tv_add_f32_dpp %0, %1, %1 row_ror:8 row_mask:0xf bank_mask:0xf" : "=&v"(q_) : "v"(ss[rr])); ss[rr] = q_; }
#define XDPP(x, n) do { float r_; asm("s_nop 1\n\tv_add_f32_dpp %0, %1, %1 row_shl:" #n " row_mask:0xf bank_mask:0xf bound_ctrl:1" : "=&v"(r_) : "v"(x)); x = r_; } while (0)
#pragma unroll
        for (int rr = 0; rr < 2; ++rr) { XDPP(fh[rr], 4); XDPP(ss[rr], 4); }
#pragma unroll
        for (int rr = 0; rr < 2; ++rr) { XDPP(fh[rr], 2); XDPP(ss[rr], 2); }
#pragma unroll
        for (int rr = 0; rr < 2; ++rr) { XDPP(fh[rr], 1); XDPP(ss[rr], 1); }
#undef XDPP
#pragma unroll
        for (int rr = 0; rr < 2; ++rr) { const int row = row0 + rr * NGW; if (row >= NROW) break;
            const float rstd = rsqrtf(ss[rr] * (1.f / DM) + EPS);
            if constexpr (L == 0) { u32x2* xb = (u32x2*)((bf16_t*)(P.ws + WS_XB) + (size_t)row * DM);
#pragma unroll
                for (int j = 0; j < 4; ++j) { u32x2 o; o.x = cvt_pk_bf16(v[rr][j][0], v[rr][j][1]); o.y = cvt_pk_bf16(v[rr][j][2], v[rr][j][3]); xb[64 * j + lane] = o; } }
            if (lane == 0) ((float*)(P.ws + WS_RSTD))[row] = rstd;
            if ((lane & 7) == 0) { float* dst = row < NPR ? P.out + OFF_LP + ((size_t)l * NPR + row) * NH : P.out + OFF_LS + ((size_t)l * NSR + (row - NPR)) * NH;
                dst[lane >> 3] = logsig_fast(fh[rr] * rstd + bfv); }
        }
#pragma unroll
        for (int rr = 0; rr < 2; ++rr)
#pragma unroll
            for (int j = 0; j < 4; ++j) cur[rr][j] = nxt[rr][j];
    }
#undef XLOAD
}

__device__ __forceinline__ void phase_fix(const Ptrs& P, int l, int gw, int NGW, int lane) {
    const float* halo = (const float*)(P.ws + WS_HALO);
    const float* cw = P.conv_w + (size_t)l * 3 * CONV + 8 * lane;
    for (int it = gw; it < NBLK64 * 2; it += NGW) {
        const int kb = it >> 1, j = it & 1, r = 64 * kb + j; const bool smp = kb >= NPR / 64;
        float um2[8], um1[8], uu[8];
        const float* hus = halo + 2 * HALO_STRIDE + (size_t)kb * 2 * CONV + 8 * lane;
        const float* prev = smp ? P.state_conv + ((size_t)l * DB + (kb - NPR / 64)) * 2 * CONV + 8 * lane : halo + (size_t)(kb - 1) * 2 * CONV + 8 * lane;
        const bool zero = !smp && (kb & 31) == 0;
#pragma unroll
        for (int c = 0; c < 8; ++c) { const float p0 = zero ? 0.f : prev[c], p1 = zero ? 0.f : prev[CONV + c], u0 = hus[c], u1 = hus[CONV + c];
            um2[c] = j == 0 ? p0 : p1; um1[c] = j == 0 ? p1 : u0; uu[c] = j == 0 ? u0 : u1; }
        const float* hb = halo + HALO_STRIDE + ((size_t)kb * 2 + j) * CONV + 8 * lane; const float* hg = halo + 3 * HALO_STRIDE + ((size_t)kb * 2 + j) * CONV + 8 * lane;
        float o[8], ss = 0.f;
#pragma unroll
        for (int c = 0; c < 8; ++c) { const float z = hb[c] * (cw[c] * um2[c] + cw[CONV + c] * um1[c] + cw[2 * CONV + c] * uu[c]); ss += z * z; o[c] = z * hg[c]; }
#pragma unroll
        for (int s = 1; s < 64; s <<= 1) ss += __shfl_xor(ss, s);
        u32x4 w; w.x = cvt_pk_bf16(o[0], o[1]); w.y = cvt_pk_bf16(o[2], o[3]); w.z = cvt_pk_bf16(o[4], o[5]); w.w = cvt_pk_bf16(o[6], o[7]);
        *(u32x4*)((bf16_t*)(P.ws + WS_MIX) + (size_t)r * DM + 512 + 8 * lane) = w;
        if (lane == 0) ((float*)(P.ws + WS_RC))[r] = rsqrtf(ss * (1.f / CONV) + EPS);
    }
    for (int row = gw * 64 + lane; row < NROW; row += NGW * 64) {
        if ((row & 63) >= 2) { const f32x4* c = (const f32x4*)((const float*)(P.ws + WS_CSS) + (size_t)row * 32);
            f32x4 a[8];
#pragma unroll
            for (int i = 0; i < 8; ++i) a[i] = c[i];
            f32x4 t = (a[0] + a[1]) + (a[2] + a[3]); t += (a[4] + a[5]) + (a[6] + a[7]);
            ((float*)(P.ws + WS_RC))[row] = rsqrtf(((t[0] + t[1]) + (t[2] + t[3])) * (1.f / CONV) + EPS); } }
}


constexpr int SKV = PAST + DSEQ;
__device__ __forceinline__ float prune_thr(const Ptrs& P, int l, int lane) {
    float mq = fabsf(P.q_g[l * HD + lane]), mk = fabsf(P.k_g[l * HD + lane]);
#pragma unroll
    for (int o = 1; o < 64; o <<= 1) { mq = fmaxf(mq, __shfl_xor(mq, o)); mk = fmaxf(mk, __shfl_xor(mk, o)); }
    return 2.f * (8.f * mq * mk * LOG2E * 1.02f) + 40.f;
}
__device__ __forceinline__ void phase_scan(const Ptrs& P, int l, int i0, int i1, int rank, int nranks, int tid, LAS unsigned char* lds) {
    LAS float* wtot = (LAS float*)lds;
    LAS float* nbl = (LAS float*)(lds + 64);
    const int lane = tid & 63, wave = tid >> 6;
    const float thr = prune_thr(P, l, lane);
    for (int it = i0 + rank; it < i1; it += nranks) {
        const bool smp = it >= NB * NH; const int bh = smp ? it - NB * NH : it, b = bh >> 3, h = bh & 7, n = smp ? SKV : SEQ;
        float v[5], s = 0.f;
#pragma unroll
        for (int j = 0; j < 5; ++j) { const int e = 5 * tid + j; float x = 0.f;
            if (e < n) { if (!smp) x = P.out[OFF_LP + ((size_t)l * NPR + (size_t)b * SEQ + e) * NH + h];
                         else x = e < PAST ? P.cache_logf[(((size_t)l * DB + b) * PAST + e) * NH + h] : P.out[OFF_LS + ((size_t)l * NSR + (size_t)b * DSEQ + (e - PAST)) * NH + h]; }
            s += x; v[j] = s; }
        float inc = s;
#pragma unroll
        for (int o = 1; o < 64; o <<= 1) { const float t = __shfl_up(inc, o); if (lane >= o) inc += t; }
        __syncthreads();
        if (lane == 63) wtot[wave] = inc;
        __syncthreads();
        float base = inc - s;
        for (int w = 0; w < wave; ++w) base += wtot[w];
        float* dst = smp ? (float*)(P.ws + WS_NBS) + (size_t)bh * SKV : (float*)(P.ws + WS_NBP) + (size_t)bh * SEQ;
#pragma unroll
        for (int j = 0; j < 5; ++j) { const int e = 5 * tid + j; if (e < n) { const float x = -(base + v[j]) * LOG2E; dst[e] = x; if (!smp) nbl[e] = x; } }
        if (!smp) {
            __syncthreads();
            if (tid < 8) { const float lim = nbl[256 * tid] - thr; int i = 0; while (i < 4 * tid && nbl[64 * i + 63] < lim) ++i;
                ((unsigned char*)(P.ws + WS_T0))[bh * 8 + tid] = (unsigned char)(i & ~1); }
        }
    }
    __syncthreads();
}

namespace attn {
using bf16x8 = __attribute__((ext_vector_type(8))) short;
using s16x4 = __attribute__((ext_vector_type(4))) short;
using f32x16 = __attribute__((ext_vector_type(16))) float;
constexpr int D = 64, DMQ = ATT;
constexpr int NW = 8, QBLK = 32, QB = QBLK * NW, KVBLK = 64;
__device__ __forceinline__ int crow(int r, int hi) { return (r & 3) + 8 * (r >> 2) + 4 * hi; }
#define SBAR() __builtin_amdgcn_sched_barrier(0)
__device__ __forceinline__ void cmask(f32x16& p0, f32x16& p1, int jb, int qrel, int hi) {
    const float NEG = -INFINITY; int kb = 64 * jb + 4 * hi;
#pragma unroll
    for (int r = 0; r < 16; ++r) { int kv = kb + (r & 3) + 8 * (r >> 2); if (kv > qrel) p0[r] = NEG; if (kv + 32 > qrel) p1[r] = NEG; }
}
constexpr int NSLOT = 3, SLOTB = 8192;
constexpr int LDS_K = 0, LDS_V = NSLOT * SLOTB, LDS_WS = 2 * NSLOT * SLOTB, LDS_NB = LDS_WS + NW * 64 * 4, LDS_OST = LDS_NB + SEQ * 4, LDS_ATT_BYTES = LDS_OST + NW * 8192;
static_assert(LDS_ATT_BYTES <= RING_BYTES, "attention scratch fits the ring region");
__device__ __forceinline__ void glds16(const void* gsrc, unsigned lds_dst) { unsigned keep;
    asm volatile("s_mov_b32 %0, m0\n\ts_mov_b32 m0, %2\n\ts_nop 0\n\tglobal_load_lds_dwordx4 %1, off\n\ts_mov_b32 m0, %0" : "=&s"(keep) : "v"(gsrc), "s"(lds_dst) : "memory"); }
__device__ __forceinline__ float max3f(float a, float b, float c) { float r; asm("v_max3_f32 %0, %1, %2, %3" : "=v"(r) : "v"(a), "v"(b), "v"(c)); return r; }
__device__ __forceinline__ float max2f(float a, float b) { float r; asm("v_max_f32_e32 %0, %1, %2" : "=v"(r) : "v"(a), "v"(b)); return r; }
__device__ __forceinline__ float fadd_s(float a, float b) { float r; asm("v_add_f32_e32 %0, %1, %2" : "=v"(r) : "v"(a), "v"(b)); return r; }
__device__ __forceinline__ float fsub_s(float a, float b) { float r; asm("v_sub_f32_e32 %0, %1, %2" : "=v"(r) : "v"(a), "v"(b)); return r; }
typedef float f32x2_t __attribute__((ext_vector_type(2))); typedef __bf16 bf16x2_t __attribute__((ext_vector_type(2)));
__device__ __forceinline__ unsigned cvtpk_s(float lo, float hi) { f32x2_t v = {lo, hi}; bf16x2_t b = __builtin_convertvector(v, bf16x2_t); return __builtin_bit_cast(unsigned, b); }
#define WAIT_BAR(N) asm volatile("s_waitcnt vmcnt(" #N ") lgkmcnt(0)\n\ts_barrier" ::: "memory")
typedef __attribute__((address_space(3))) const char* lds_cptr;
typedef short v4i16_t __attribute__((ext_vector_type(4)));
__device__ __forceinline__ void kload8(bf16x8* kf, lds_cptr kp) {
    kf[0] = *(const LAS bf16x8*)(kp);        kf[1] = *(const LAS bf16x8*)(kp + 512);
    kf[2] = *(const LAS bf16x8*)(kp + 2048); kf[3] = *(const LAS bf16x8*)(kp + 2560);
    kf[4] = *(const LAS bf16x8*)(kp + 4096); kf[5] = *(const LAS bf16x8*)(kp + 4608);
    kf[6] = *(const LAS bf16x8*)(kp + 6144); kf[7] = *(const LAS bf16x8*)(kp + 6656);
}
__device__ __forceinline__ void kload2(bf16x8* kf, lds_cptr kp, int j) { kf[2 * j] = *(const LAS bf16x8*)(kp + j * 2048); kf[2 * j + 1] = *(const LAS bf16x8*)(kp + j * 2048 + 512); }
__device__ __forceinline__ s16x4 vtr(lds_cptr p) { return __builtin_bit_cast(s16x4, __builtin_amdgcn_ds_read_tr16_b64_v4i16((LAS v4i16_t*)p)); }
__device__ __forceinline__ float rowmax(const f32x16& p0, const f32x16& p1) {
    float a = max3f(p0[0], p0[1], p1[0]), b = max3f(p0[2], p0[3], p1[1]); a = max3f(a, p1[2], p1[3]);
#pragma unroll
    for (int r = 4; r < 16; r += 4) { a = max3f(a, p0[r], p0[r + 1]); b = max3f(b, p0[r + 2], p0[r + 3]); a = max3f(a, p1[r], p1[r + 1]); b = max3f(b, p1[r + 2], p1[r + 3]); }
    const float m = max2f(a, b);
    auto rr = __builtin_amdgcn_permlane32_swap(__float_as_uint(m), __float_as_uint(m), false, false);
    return max2f(__uint_as_float(rr[0]), __uint_as_float(rr[1]));
}
__device__ __forceinline__ void pv(f32x16* o, int vb, bf16x8 pa0, bf16x8 pa1, bf16x8 pa2, bf16x8 pa3) {
#pragma unroll
    for (int d0 = 0; d0 < 2; ++d0) { s16x4 lo[4], hi[4];
#pragma unroll
        for (int ks = 0; ks < 4; ++ks) {
            asm volatile("ds_read_b64_tr_b16 %0,%1 offset:%c2" : "=&v"(lo[ks]) : "v"(vb), "i"(d0 * 4096 + ks * 1024) : "memory");
            asm volatile("ds_read_b64_tr_b16 %0,%1 offset:%c2" : "=&v"(hi[ks]) : "v"(vb), "i"(d0 * 4096 + ks * 1024 + 512) : "memory"); }
        asm volatile("s_waitcnt lgkmcnt(0)" ::: "memory"); SBAR();
#define PK(k) (bf16x8){lo[k][0], lo[k][1], lo[k][2], lo[k][3], hi[k][0], hi[k][1], hi[k][2], hi[k][3]}
        o[d0] = __builtin_amdgcn_mfma_f32_32x32x16_bf16(pa0, PK(0), o[d0], 0, 0, 0);
        o[d0] = __builtin_amdgcn_mfma_f32_32x32x16_bf16(pa1, PK(1), o[d0], 0, 0, 0);
        o[d0] = __builtin_amdgcn_mfma_f32_32x32x16_bf16(pa2, PK(2), o[d0], 0, 0, 0);
        o[d0] = __builtin_amdgcn_mfma_f32_32x32x16_bf16(pa3, PK(3), o[d0], 0, 0, 0);
#undef PK
    }
}

template <int THRL> __device__ __forceinline__ void attn_unit(const Ptrs& P, int l, int b, int h, int qb, const int T0, const float Mb, unsigned* qctr, volatile LAS unsigned* slot, char* shm, int tid) {
    asm volatile("" : "+v"(tid));
    const int lane = tid & 63, r32 = lane & 31, hi = lane >> 5; const int wid = __builtin_amdgcn_readfirstlane(tid >> 6);
    const bf16_t* Q = (const bf16_t*)(P.ws + WS_Q); const bf16_t* K = (const bf16_t*)(P.ws + WS_KB); const bf16_t* V = (const bf16_t*)(P.ws + WS_VB);
    const long rowbase = (long)b * SEQ; const int q0 = qb * QB;
    const bf16_t* Qw = Q + (rowbase + q0 + wid * QBLK) * DMQ + h * D;
    const bf16_t* Kh = K + rowbase * DMQ + h * D, *Vh = V + rowbase * DMQ + h * D;
    const unsigned lds0 = (unsigned)(uintptr_t)shm;
    float* wsf = (float*)(shm + LDS_WS) + wid * 64;
    const float* nbg = (const float*)(P.ws + WS_NBP) + (size_t)(b * NH + h) * SEQ;
    const bf16_t* ksrc = K + ((long)(b * NH + h) * 32 + T0) * 4096 + wid * 512 + lane * 8;
    const bf16_t* vsrc = V + ((long)(b * NH + h) * 32 + T0) * 4096 + wid * 512 + lane * 8;
    const unsigned kdst = lds0 + LDS_K + wid * 1024, vdst = lds0 + LDS_V + wid * 1024;
#define DMA_K(t, slot) glds16(ksrc + (long)(t) * 4096, (unsigned)__builtin_amdgcn_readfirstlane(kdst + (slot)))
#define DMA_V(t, slot) glds16(vsrc + (long)(t) * 4096, (unsigned)__builtin_amdgcn_readfirstlane(vdst + (slot)))
    const int vb0 = (int)(lds0 + LDS_V) + ((lane >> 4) & 1) * 32 + (lane & 3) * 8 + (4 * hi + ((lane & 15) >> 2)) * 64;
    bf16x8 kf[8];
    const lds_cptr shm3 = (lds_cptr)shm; const lds_cptr kp0 = shm3 + LDS_K + hi * 1024 + r32 * 16; const lds_cptr vp0 = shm3 + LDS_V + ((lane >> 4) & 1) * 32 + (lane & 3) * 8 + (4 * hi + ((lane & 15) >> 2)) * 64;
    const lds_cptr nb3 = shm3 + LDS_NB + 16 * hi + 256 * T0;
    const lds_cptr nbl0 = shm3 + LDS_NB + 256 * T0 + 252;
    const int NT = (q0 + QB) / KVBLK - T0;
    const int xd4 = tid & 15, xkq = tid >> 4;
    const lds_cptr xk0 = shm3 + LDS_K + (xd4 >> 1) * 1024 + xkq * 16 + (xd4 & 1) * 8;
    const lds_cptr xv0 = shm3 + LDS_V + (xd4 >> 3) * 4096 + xkq * 64 + (xd4 & 7) * 8;
    float* const xko = P.out + OFF_KP + ((size_t)l * NPR + rowbase + 64 * T0 + xkq) * ATT + h * D + 4 * xd4;
#define XPAND(src, pstride, dst) do { _Pragma("unroll") for (int ps_ = 0; ps_ < 2; ++ps_) { const u32x2 w_ = *(const LAS u32x2*)((src) + ps_ * (pstride)); \
        const f32x4 x_ = (f32x4){bf2f(w_.x & 0xffffu), __builtin_bit_cast(float, w_.x & 0xffff0000u), bf2f(w_.y & 0xffffu), __builtin_bit_cast(float, w_.y & 0xffff0000u)}; \
        __builtin_nontemporal_store(x_, (f32x4*)((dst) + (size_t)(32 * ps_) * ATT)); } } while (0)
#define XP(t) do { if ((t) + 1 >= NT - 4 && (t) + 1 < NT) XPAND(xk0 + sl_next, 512, xko + (size_t)(64 * ((t) + 1)) * ATT); \
                   if ((t) - 1 >= NT - 4) XPAND(xv0 + sl_prev, 2048, xko + (OFF_VP - OFF_KP) + (size_t)(64 * ((t) - 1)) * ATT); } while (0)
    DMA_K(0, 0); DMA_V(0, 0); DMA_K(1, SLOTB);
    { const int e = 64 * T0 + 4 * tid;
      if (e < q0 + QB) { const f32x4 x = *(const f32x4*)(nbg + e); *(LAS f32x4*)((LAS char*)shm3 + LDS_NB + 4 * e) = x; } }
    bf16x8 qr[4];
#pragma unroll
    for (int d0 = 0; d0 < 4; ++d0) qr[d0] = *reinterpret_cast<const bf16x8*>(&Qw[(long)r32 * DMQ + d0 * 16 + hi * 8]);
    float mhat = 0.f, l_reg = 0.f; f32x16 o[2]; o[0] = f32x16{}; o[1] = f32x16{};
    const int qrel = wid * QBLK + r32;
#define CMASK(P0, P1, t) do { int jb_ = (t) - (NT - 4); if (jb_ >= 0) cmask(P0, P1, jb_, qrel, hi); } while (0)
    u32x4 qmw = (u32x4){0u, 0u, 0u, 0u};
    const u32x4 konew = hi == 0 ? (u32x4){0x3F803F80u, 0x00003F80u, 0u, 0u} : (u32x4){0u, 0u, 0u, 0u};
#define SETQM() do { const unsigned a_ = cvtpk_s(mhat, 0.f) & 0xffffu; const float r1_ = mhat - __uint_as_float(a_ << 16); \
      const unsigned b_ = cvtpk_s(r1_, 0.f) & 0xffffu; const float r2_ = r1_ - __uint_as_float(b_ << 16); const unsigned c_ = cvtpk_s(r2_, 0.f) & 0xffffu; \
      qmw.x = hi == 0 ? ((a_ | (b_ << 16)) ^ 0x80008000u) : 0u; qmw.y = hi == 0 ? (c_ ^ 0x8000u) : 0u; } while (0)
#define REFMM(C0, C1) do { C0 = __builtin_amdgcn_mfma_f32_32x32x16_bf16(__builtin_bit_cast(bf16x8, konew), __builtin_bit_cast(bf16x8, qmw), C0, 0, 0, 0); \
      C1 = __builtin_amdgcn_mfma_f32_32x32x16_bf16(__builtin_bit_cast(bf16x8, konew), __builtin_bit_cast(bf16x8, qmw), C1, 0, 0, 0); } while (0)
#define BIAS(C0, C1, t) do { const lds_cptr nbp_ = nb3 + 256 * (t); \
      _Pragma("unroll") for (int g_ = 0; g_ < 4; ++g_) { const f32x4 x_ = *(const LAS f32x4*)(nbp_ + 32 * g_), y_ = *(const LAS f32x4*)(nbp_ + 128 + 32 * g_); \
        _Pragma("unroll") for (int j_ = 0; j_ < 4; ++j_) { C0[4 * g_ + j_] = x_[j_]; C1[4 * g_ + j_] = y_[j_]; } } } while (0)
    bool resc = false;
#define START(P0, P1) do { const float rm = rowmax(P0, P1); resc = false; \
    { const float dl = rm; mhat = fadd_s(mhat, dl); SETQM(); \
      _Pragma("unroll") for (int r = 0; r < 16; ++r) { P0[r] = fsub_s(P0[r], dl); P1[r] = fsub_s(P1[r], dl); } } \
    _Pragma("unroll") for (int r = 0; r < 16; ++r) P0[r] = __builtin_amdgcn_exp2f(P0[r]); } while (0)
#define RESC() do { if (resc) { asm volatile("s_waitcnt lgkmcnt(0)" ::: "memory"); \
      _Pragma("unroll") for (int d_ = 0; d_ < 2; ++d_) _Pragma("unroll") for (int r = 0; r < 16; ++r) o[d_][r] *= wsf[crow(r, hi)]; } } while (0)
    f32x16 pA0, pA1, pB0, pB1;
    int sl_prev = 0, sl_cur = 0, sl_next = SLOTB;
#define ROT() do { sl_prev = sl_cur; sl_cur = sl_next; sl_next = (sl_next == (NSLOT - 1) * SLOTB) ? 0 : sl_next + SLOTB; } while (0)
    DMA_K(2, 2 * SLOTB);
    WAIT_BAR(3);
    if (NT == 4) XPAND(xk0, 512, xko);
    BIAS(pA0, pA1, 0);
    { const char* kb = shm + LDS_K + hi * 1024 + r32 * 16;
#pragma unroll
      for (int d0 = 0; d0 < 4; ++d0) { const bf16x8 b0 = *reinterpret_cast<const bf16x8*>(kb + d0 * 2048); const bf16x8 b1 = *reinterpret_cast<const bf16x8*>(kb + d0 * 2048 + 512);
        pA0 = __builtin_amdgcn_mfma_f32_32x32x16_bf16(b0, qr[d0], pA0, 0, 0, 0); pA1 = __builtin_amdgcn_mfma_f32_32x32x16_bf16(b1, qr[d0], pA1, 0, 0, 0); } }
    asm volatile("s_nop 15\n\ts_nop 7" : "+v"(pA0), "+v"(pA1)); CMASK(pA0, pA1, 0);
    START(pA0, pA1);
    _Pragma("unroll") for (int r = 0; r < 16; ++r) pA1[r] = __builtin_amdgcn_exp2f(pA1[r]);
    WAIT_BAR(0);
    if (NT == 4) XPAND(xk0 + SLOTB, 512, xko + (size_t)64 * ATT);
    DMA_K(3, 0); DMA_V(1, SLOTB);
    ROT();
    kload8(kf, kp0 + sl_cur);
    WAIT_BAR(2);
    s16x4 vlo[8], vhi[8]; u32x4 pw0, pw1, pw2, pw3;
#define PKW(P, B) cvtpk_s(P[B], P[B + 1])
#define PAF(k) __builtin_bit_cast(bf16x8, pw##k)
#define VFR(i) (bf16x8){vlo[i][0], vlo[i][1], vlo[i][2], vlo[i][3], vhi[i][0], vhi[i][1], vhi[i][2], vhi[i][3]}
#define PIN(x) asm volatile("" : "+v"(x))
#define MX3(a, b, c) __builtin_fmaxf(__builtin_fmaxf((a), (b)), (c))
#define GAPA(MF, A0, A1, A2, A3, W0, W1, PW) do { MF; sacc += A0; sacc += A1; sacc += A2; sacc += A3; PIN(sacc); W0; W1; PIN(PW); SBAR(); } while (0)
#define EX(v) __builtin_amdgcn_exp2f(v)
#define GAPB(MF, X, B) do { MF; X[B] = EX(X[B]); X[B + 1] = EX(X[B + 1]); X[B + 2] = EX(X[B + 2]); X[B + 3] = EX(X[B + 3]); PIN(X); SBAR(); } while (0)
#define VRD(i) do { vlo[i] = vtr(vp_ + (((i) >> 2) * 4096 + ((i) & 3) * 1024)); vhi[i] = vtr(vp_ + (((i) >> 2) * 4096 + ((i) & 3) * 1024 + 512)); } while (0)
#define KRD(G, j) do { if (G) { kload2(kf, kp0 + sl_next, j); SBAR(); } } while (0)
#define STEP(C0, C1, P0, P1, t, GK, GV, GL) do { SBAR(); \
    BIAS(C0, C1, t); SBAR(); REFMM(C0, C1); SBAR(); \
    const lds_cptr vp_ = vp0 + sl_prev; \
    VRD(0); SBAR(); float sacc = (P0[0] + P0[1]); \
    GAPA(C0 = __builtin_amdgcn_mfma_f32_32x32x16_bf16(kf[0], qr[0], C0, 0, 0, 0), P0[2], P0[3], P0[4], P0[5],     pw0[0] = PKW(P0, 0), pw0[1] = PKW(P0, 2), pw0); \
    VRD(4); SBAR(); GAPA(C1 = __builtin_amdgcn_mfma_f32_32x32x16_bf16(kf[1], qr[0], C1, 0, 0, 0), P0[6], P0[7], P0[8], P0[9],     pw0[2] = PKW(P0, 4), pw0[3] = PKW(P0, 6), pw0); \
    VRD(1); SBAR(); GAPA(C0 = __builtin_amdgcn_mfma_f32_32x32x16_bf16(kf[2], qr[1], C0, 0, 0, 0),   P0[10], P0[11], P0[12], P0[13], pw1[0] = PKW(P0, 8), pw1[1] = PKW(P0, 10), pw1); \
    VRD(5); SBAR(); GAPA(C1 = __builtin_amdgcn_mfma_f32_32x32x16_bf16(kf[3], qr[1], C1, 0, 0, 0),   P0[14], P0[15], P1[0], P1[1],   pw1[2] = PKW(P0, 12), pw1[3] = PKW(P0, 14), pw1); \
    VRD(2); SBAR(); GAPA(C0 = __builtin_amdgcn_mfma_f32_32x32x16_bf16(kf[4], qr[2], C0, 0, 0, 0),   P1[2], P1[3], P1[4], P1[5],     pw2[0] = PKW(P1, 0), pw2[1] = PKW(P1, 2), pw2); \
    VRD(6); SBAR(); GAPA(C1 = __builtin_amdgcn_mfma_f32_32x32x16_bf16(kf[5], qr[2], C1, 0, 0, 0),   P1[6], P1[7], P1[8], P1[9],     pw2[2] = PKW(P1, 4), pw2[3] = PKW(P1, 6), pw2); \
    VRD(3); SBAR(); GAPA(C0 = __builtin_amdgcn_mfma_f32_32x32x16_bf16(kf[6], qr[3], C0, 0, 0, 0),   P1[10], P1[11], P1[12], P1[13], pw3[0] = PKW(P1, 8), pw3[1] = PKW(P1, 10), pw3); \
    VRD(7); SBAR(); GAPA(C1 = __builtin_amdgcn_mfma_f32_32x32x16_bf16(kf[7], qr[3], C1, 0, 0, 0),   P1[14], P1[15], 0.f, 0.f,       pw3[2] = PKW(P1, 12), pw3[3] = PKW(P1, 14), pw3); \
    l_reg += sacc; \
    if (GK) { DMA_K((t) + 3, sl_cur); } if (GV) { DMA_V((t) + 1, sl_next); } \
    CMASK(C0, C1, t); \
    resc = false; \
      \
    if (__builtin_expect(__any(*(const LAS float*)(nbl0 + 256 * (t)) + Mb - mhat > 48.f), 0)) { \
      float a = MX3(C0[0], C0[1], C1[0]), b = MX3(C0[2], C0[3], C1[1]); a = MX3(a, C1[2], C1[3]); \
      _Pragma("unroll") for (int r = 4; r < 16; r += 4) { a = MX3(a, C0[r], C0[r + 1]); b = MX3(b, C0[r + 2], C0[r + 3]); a = MX3(a, C1[r], C1[r + 1]); b = MX3(b, C1[r + 2], C1[r + 3]); } \
      float rm = __builtin_fmaxf(a, b); { auto rr = __builtin_amdgcn_permlane32_swap(__float_as_uint(rm), __float_as_uint(rm), false, false); rm = __builtin_fmaxf(__uint_as_float(rr[0]), __uint_as_float(rr[1])); } \
      if (__builtin_expect(__any(rm > (float)THRL), 0)) { const float dl = __builtin_fmaxf(rm, 0.f); mhat += dl; SETQM(); \
        _Pragma("unroll") for (int r = 0; r < 16; ++r) { C0[r] -= dl; C1[r] -= dl; } \
        const float f = __builtin_amdgcn_exp2f(-dl); l_reg *= f; if (hi == 0) wsf[r32] = f; resc = true; } } \
    SBAR(); \
    GAPB(o[0] = __builtin_amdgcn_mfma_f32_32x32x16_bf16(PAF(0), VFR(0), o[0], 0, 0, 0), C0, 0); \
    GAPB(o[1] = __builtin_amdgcn_mfma_f32_32x32x16_bf16(PAF(0), VFR(4), o[1], 0, 0, 0), C0, 4); \
    KRD(GL, 0); GAPB(o[0] = __builtin_amdgcn_mfma_f32_32x32x16_bf16(PAF(1), VFR(1), o[0], 0, 0, 0), C0, 8); \
    KRD(GL, 1); GAPB(o[1] = __builtin_amdgcn_mfma_f32_32x32x16_bf16(PAF(1), VFR(5), o[1], 0, 0, 0), C0, 12); \
    KRD(GL, 2); GAPB(o[0] = __builtin_amdgcn_mfma_f32_32x32x16_bf16(PAF(2), VFR(2), o[0], 0, 0, 0), C1, 0); \
    KRD(GL, 3); GAPB(o[1] = __builtin_amdgcn_mfma_f32_32x32x16_bf16(PAF(2), VFR(6), o[1], 0, 0, 0), C1, 4); \
    GAPB(o[0] = __builtin_amdgcn_mfma_f32_32x32x16_bf16(PAF(3), VFR(3), o[0], 0, 0, 0), C1, 8); \
    GAPB(o[1] = __builtin_amdgcn_mfma_f32_32x32x16_bf16(PAF(3), VFR(7), o[1], 0, 0, 0), C1, 12); \
    } while (0)
    int t = 1;
#undef CMASK
#define CMASK(P0, P1, t) do {} while (0)
    for (; t + 5 < NT; t += 2) {
        STEP(pB0, pB1, pA0, pA1, t, true, true, true);     WAIT_BAR(2); RESC(); ROT();
        STEP(pA0, pA1, pB0, pB1, t + 1, true, true, true); WAIT_BAR(2); RESC(); ROT();
    }
#undef CMASK
#define CMASK(P0, P1, t) do { int jb_ = (t) - (NT - 4); if (jb_ >= 0) cmask(P0, P1, jb_, qrel, hi); } while (0)
#define ENDW(tt) do { if ((tt) + 3 < NT) { WAIT_BAR(2); } else if ((tt) + 2 < NT) { WAIT_BAR(1); } else { WAIT_BAR(0); } } while (0)
    for (; t + 1 < NT; t += 2) {
        XP(t);     STEP(pB0, pB1, pA0, pA1, t, (t + 3 < NT), (t + 1 < NT), (t + 1 < NT));         ENDW(t);     RESC(); ROT();
        XP(t + 1); STEP(pA0, pA1, pB0, pB1, t + 1, (t + 4 < NT), (t + 2 < NT), (t + 2 < NT));     ENDW(t + 1); RESC(); ROT();
    }
    XP(NT - 1); XPAND(xv0 + sl_cur, 2048, xko + (OFF_VP - OFF_KP) + (size_t)(64 * (NT - 1)) * ATT);
    STEP(pB0, pB1, pA0, pA1, NT - 1, false, false, false); RESC();
    { float sacc = pB0[0] + pB0[1]; _Pragma("unroll") for (int r = 2; r < 16; ++r) sacc += pB0[r]; _Pragma("unroll") for (int r = 0; r < 16; ++r) sacc += pB1[r]; l_reg += sacc;
      pw0 = (u32x4){PKW(pB0, 0), PKW(pB0, 2), PKW(pB0, 4), PKW(pB0, 6)}; pw1 = (u32x4){PKW(pB0, 8), PKW(pB0, 10), PKW(pB0, 12), PKW(pB0, 14)}; pw2 = (u32x4){PKW(pB1, 0), PKW(pB1, 2), PKW(pB1, 4), PKW(pB1, 6)}; pw3 = (u32x4){PKW(pB1, 8), PKW(pB1, 10), PKW(pB1, 12), PKW(pB1, 14)};
      SBAR(); pv(o, vb0 + sl_cur, PAF(0), PAF(1), PAF(2), PAF(3)); }
#undef PKW
#undef PAF
#undef VFR
#undef PIN
#undef MX3
#undef GAPA
#undef GAPB
#undef EX
#undef VRD
#undef KRD
#undef STEP
#undef ENDW
    unsigned nxu = 0; if (tid == 0) nxu = __hip_atomic_fetch_add(qctr, 1u, __ATOMIC_RELAXED, __HIP_MEMORY_SCOPE_AGENT);
    const long grow0 = rowbase + q0 + wid * QBLK;
    u32x4 gav[4];
#pragma unroll
    for (int i = 0; i < 4; ++i) gav[i] = *(const u32x4*)((const bf16_t*)(P.ws + WS_GA) + (grow0 + i * 8 + (lane >> 3)) * ATT + h * D + (lane & 7) * 8);
    { auto rr = __builtin_amdgcn_permlane32_swap(__float_as_uint(l_reg), __float_as_uint(l_reg), false, false); l_reg = __uint_as_float(rr[0]) + __uint_as_float(rr[1]); }
    if (hi == 0) wsf[32 + r32] = l_reg; asm volatile("s_waitcnt lgkmcnt(0)" ::: "memory");
    float rli[16];
#pragma unroll
    for (int r = 0; r < 16; ++r) rli[r] = __builtin_amdgcn_rcpf(wsf[32 + crow(r, hi)]);
    { float* stg = (float*)(shm + LDS_OST) + wid * 2048;
#pragma unroll
      for (int r = 0; r < 16; ++r) { const int orow = crow(r, hi);
#pragma unroll
        for (int d0 = 0; d0 < 2; ++d0) stg[orow * 64 + d0 * 32 + r32] = o[d0][r] * rli[r]; }
      asm volatile("s_waitcnt lgkmcnt(0)" ::: "memory");
      f32x4 sa0[4], sa1[4];
#pragma unroll
      for (int i = 0; i < 4; ++i) { const int row = i * 8 + (lane >> 3), ch = lane & 7; sa0[i] = *(const f32x4*)(stg + row * 64 + ch * 8); sa1[i] = *(const f32x4*)(stg + row * 64 + ch * 8 + 4); }
#pragma unroll
      for (int i = 0; i < 4; ++i) { const int row = i * 8 + (lane >> 3), ch = lane & 7; const long grow = grow0 + row;
        const f32x4 a0 = sa0[i], a1 = sa1[i];
        float ss = ((a0[0] * a0[0] + a0[1] * a0[1]) + (a0[2] * a0[2] + a0[3] * a0[3])) + ((a1[0] * a1[0] + a1[1] * a1[1]) + (a1[2] * a1[2] + a1[3] * a1[3]));
        { float r_; asm("s_nop 1\n\tv_add_f32_dpp %0, %1, %1 row_shl:4 row_mask:0xf bank_mask:0xf bound_ctrl:1" : "=&v"(r_) : "v"(ss)); ss = r_;
          asm("s_nop 1\n\tv_add_f32_dpp %0, %1, %1 row_shl:2 row_mask:0xf bank_mask:0xf bound_ctrl:1" : "=&v"(r_) : "v"(ss)); ss = r_;
          asm("s_nop 1\n\tv_add_f32_dpp %0, %1, %1 row_shl:1 row_mask:0xf bank_mask:0xf bound_ctrl:1" : "=&v"(r_) : "v"(ss)); ss = r_; }
        const u32x4 g = gav[i];
        u32x4 w;
        w.x = cvt_pk_bf16(a0[0] * bf2f(g.x & 0xffffu), a0[1] * bf2f(g.x >> 16)); w.y = cvt_pk_bf16(a0[2] * bf2f(g.y & 0xffffu), a0[3] * bf2f(g.y >> 16));
        w.z = cvt_pk_bf16(a1[0] * bf2f(g.z & 0xffffu), a1[1] * bf2f(g.z >> 16)); w.w = cvt_pk_bf16(a1[2] * bf2f(g.w & 0xffffu), a1[3] * bf2f(g.w >> 16));
        *(u32x4*)((bf16_t*)(P.ws + WS_MIX) + grow * DM + h * D + ch * 8) = w;
        if (ch == 0) ((float*)(P.ws + WS_ASS))[grow * NH + h] = ss; } }
    if (tid == 0) *slot = nxu;
    asm volatile("s_waitcnt lgkmcnt(0)\n\ts_barrier" ::: "memory");
#undef XP
#undef XPAND
#undef SETQM
#undef REFMM
#undef DMA_K
#undef DMA_V
#undef CMASK
#undef BIAS
#undef START
#undef RESC
#undef ROT
}
#undef SBAR
#undef WAIT_BAR
}

namespace sattn {
using bf16x8 = __attribute__((ext_vector_type(8))) short;
using f32x16 = __attribute__((ext_vector_type(16))) float;
constexpr int S_NB = 0, S_WS = 8704, S_ML = 10752, S_OP = 14848, S_END = S_OP + 131072;
static_assert(S_END <= LDS_BYTES, "sample attention LDS");
__device__ __forceinline__ int crow(int r, int hi) { return (r & 3) + 8 * (r >> 2) + 4 * hi; }
__device__ __forceinline__ bf16x8 pack8(const f32x4 a, const f32x4 c) { u32x4 w; w.x = cvt_pk_bf16(a[0], a[1]); w.y = cvt_pk_bf16(a[2], a[3]); w.z = cvt_pk_bf16(c[0], c[1]); w.w = cvt_pk_bf16(c[2], c[3]); return __builtin_bit_cast(bf16x8, w); }
__device__ __forceinline__ float halfmax(float m) { auto rr = __builtin_amdgcn_permlane32_swap(__float_as_uint(m), __float_as_uint(m), false, false); return fmaxf(__uint_as_float(rr[0]), __uint_as_float(rr[1])); }
__device__ __forceinline__ void unit(const Ptrs& P, int l, int b, int h, char* shm, int tid) {
    asm volatile("" : "+v"(tid));
    const int lane = tid & 63, r32 = lane & 31, hi = lane >> 5; const int wid = __builtin_amdgcn_readfirstlane(tid >> 6);
    const int bh = b * NH + h; const size_t srow0 = (size_t)NPR + (size_t)b * DSEQ;
    { const float* nbg = (const float*)(P.ws + WS_NBS) + (size_t)bh * SKV;
      for (int i = tid; i < SKV / 4; i += NWAVES * 64) *(f32x4*)(shm + S_NB + 16 * i) = *(const f32x4*)(nbg + 4 * i); }
    const bf16_t* Qg = (const bf16_t*)(P.ws + WS_Q) + srow0 * ATT + h * HD;
    bf16x8 qr[2][4];
#pragma unroll
    for (int qb = 0; qb < 2; ++qb)
#pragma unroll
        for (int d0 = 0; d0 < 4; ++d0) qr[qb][d0] = *(const bf16x8*)(Qg + (size_t)(32 * qb + r32) * ATT + 16 * d0 + 8 * hi);
    f32x16 o[2][2];
#pragma unroll
    for (int qb = 0; qb < 2; ++qb)
#pragma unroll
        for (int d0 = 0; d0 < 2; ++d0) o[qb][d0] = f32x16{};
    float mref[2] = {0.f, 0.f}, lsum[2] = {0.f, 0.f};
    float* wsf = (float*)(shm + S_WS) + wid * 64;
    const float* ckb = P.cache_k + (((size_t)l * DB + b) * PAST) * ATT + h * HD; const float* cvb = P.cache_v + (((size_t)l * DB + b) * PAST) * ATT + h * HD;
    const bf16_t* Kn = (const bf16_t*)(P.ws + WS_KB) + srow0 * ATT + h * HD; const bf16_t* Vn = (const bf16_t*)(P.ws + WS_VB) + srow0 * ATT + h * HD;
    __syncthreads();
    for (int j = wid; j < SKV / 32; j += NWAVES) {
        const int kv0 = 32 * j; const bool cached = j < PAST / 32;
        bf16x8 kf[4], vf[2][2];
        if (cached) {
            const float* kp = ckb + (size_t)(kv0 + r32) * ATT + 8 * hi;
#pragma unroll
            for (int d0 = 0; d0 < 4; ++d0) kf[d0] = pack8(*(const f32x4*)(kp + 16 * d0), *(const f32x4*)(kp + 16 * d0 + 4));
#pragma unroll
            for (int ks = 0; ks < 2; ++ks)
#pragma unroll
                for (int d0 = 0; d0 < 2; ++d0) { const float* vp = cvb + (size_t)(kv0 + 16 * ks + 4 * hi) * ATT + 32 * d0 + r32;
                    f32x4 a, c;
#pragma unroll
                    for (int jj = 0; jj < 4; ++jj) { a[jj] = vp[(size_t)jj * ATT]; c[jj] = vp[(size_t)(8 + jj) * ATT]; }
                    vf[ks][d0] = pack8(a, c); }
        } else {
            const int kn0 = kv0 - PAST;
#pragma unroll
            for (int d0 = 0; d0 < 4; ++d0) kf[d0] = *(const bf16x8*)(Kn + (size_t)(kn0 + r32) * ATT + 16 * d0 + 8 * hi);
#pragma unroll
            for (int ks = 0; ks < 2; ++ks)
#pragma unroll
                for (int d0 = 0; d0 < 2; ++d0) { const bf16_t* vp = Vn + (size_t)(kn0 + 16 * ks + 4 * hi) * ATT + 32 * d0 + r32;
                    bf16x8 x;
#pragma unroll
                    for (int jj = 0; jj < 4; ++jj) { x[jj] = (short)vp[(size_t)jj * ATT]; x[4 + jj] = (short)vp[(size_t)(8 + jj) * ATT]; }
                    vf[ks][d0] = x; }
        }
        f32x16 p[2];
#pragma unroll
        for (int g = 0; g < 4; ++g) { const f32x4 x = *(const f32x4*)(shm + S_NB + 4 * (kv0 + 8 * g + 4 * hi));
#pragma unroll
            for (int jj = 0; jj < 4; ++jj) { p[0][4 * g + jj] = x[jj] - mref[0]; p[1][4 * g + jj] = x[jj] - mref[1]; } }
#pragma unroll
        for (int qb = 0; qb < 2; ++qb)
#pragma unroll
            for (int d0 = 0; d0 < 4; ++d0) p[qb] = __builtin_amdgcn_mfma_f32_32x32x16_bf16(kf[d0], qr[qb][d0], p[qb], 0, 0, 0);
        if (!cached) { const int kn0 = kv0 - PAST;
#pragma unroll
            for (int qb = 0; qb < 2; ++qb)
#pragma unroll
                for (int r = 0; r < 16; ++r) if (kn0 + crow(r, hi) > 32 * qb + r32) p[qb][r] = -INFINITY; }
        bf16x8 pa[2][2];
#pragma unroll
        for (int qb = 0; qb < 2; ++qb) {
            float rm = p[qb][0];
#pragma unroll
            for (int r = 1; r < 16; ++r) rm = fmaxf(rm, p[qb][r]);
            rm = halfmax(rm);
            if (__any(rm > 8.f)) { const float dl = fmaxf(rm, 0.f); mref[qb] += dl;
#pragma unroll
                for (int r = 0; r < 16; ++r) p[qb][r] -= dl;
                const float f = __builtin_amdgcn_exp2f(-dl); lsum[qb] *= f; if (hi == 0) wsf[32 * qb + r32] = f;
#pragma unroll
                for (int r = 0; r < 16; ++r) { const float fr = wsf[32 * qb + crow(r, hi)]; o[qb][0][r] *= fr; o[qb][1][r] *= fr; } }
            float s = 0.f;
#pragma unroll
            for (int r = 0; r < 16; ++r) { p[qb][r] = __builtin_amdgcn_exp2f(p[qb][r]); s += p[qb][r]; }
            lsum[qb] += s;
#pragma unroll
            for (int ks = 0; ks < 2; ++ks) pa[qb][ks] = pack8((f32x4){p[qb][8 * ks], p[qb][8 * ks + 1], p[qb][8 * ks + 2], p[qb][8 * ks + 3]}, (f32x4){p[qb][8 * ks + 4], p[qb][8 * ks + 5], p[qb][8 * ks + 6], p[qb][8 * ks + 7]});
        }
#pragma unroll
        for (int qb = 0; qb < 2; ++qb)
#pragma unroll
            for (int d0 = 0; d0 < 2; ++d0)
#pragma unroll
                for (int ks = 0; ks < 2; ++ks) o[qb][d0] = __builtin_amdgcn_mfma_f32_32x32x16_bf16(pa[qb][ks], vf[ks][d0], o[qb][d0], 0, 0, 0);
    }
    float* ML = (float*)(shm + S_ML); float* OP = (float*)(shm + S_OP) + wid * 4096;
#pragma unroll
    for (int qb = 0; qb < 2; ++qb) { auto rr = __builtin_amdgcn_permlane32_swap(__float_as_uint(lsum[qb]), __float_as_uint(lsum[qb]), false, false);
        const float lt = __uint_as_float(rr[0]) + __uint_as_float(rr[1]);
        if (hi == 0) { ML[wid * 64 + 32 * qb + r32] = mref[qb]; ML[512 + wid * 64 + 32 * qb + r32] = lt; }
#pragma unroll
        for (int d0 = 0; d0 < 2; ++d0)
#pragma unroll
            for (int r = 0; r < 16; ++r) OP[(32 * qb + crow(r, hi)) * 64 + 32 * d0 + r32] = o[qb][d0][r]; }
    __syncthreads();
    { const int q = tid >> 3, ch = tid & 7;
      float mm = ML[q];
#pragma unroll
      for (int w = 1; w < NWAVES; ++w) mm = fmaxf(mm, ML[w * 64 + q]);
      float lt = 0.f; f32x4 a0 = (f32x4){0.f, 0.f, 0.f, 0.f}, a1 = a0;
#pragma unroll
      for (int w = 0; w < NWAVES; ++w) { const float wt = __builtin_amdgcn_exp2f(ML[w * 64 + q] - mm); lt += ML[512 + w * 64 + q] * wt;
          const float* op = (const float*)(shm + S_OP) + w * 4096 + q * 64 + 8 * ch; a0 += *(const f32x4*)op * wt; a1 += *(const f32x4*)(op + 4) * wt; }
      const float il = 1.f / lt; a0 *= il; a1 *= il;
      float ss = ((a0[0] * a0[0] + a0[1] * a0[1]) + (a0[2] * a0[2] + a0[3] * a0[3])) + ((a1[0] * a1[0] + a1[1] * a1[1]) + (a1[2] * a1[2] + a1[3] * a1[3]));
      ss += __shfl_xor(ss, 1); ss += __shfl_xor(ss, 2); ss += __shfl_xor(ss, 4);
      const size_t grow = srow0 + q;
      const u32x4 g = *(const u32x4*)((const bf16_t*)(P.ws + WS_GA) + grow * ATT + h * HD + ch * 8);
      u32x4 w;
      w.x = cvt_pk_bf16(a0[0] * bf2f(g.x & 0xffffu), a0[1] * bf2f(g.x >> 16)); w.y = cvt_pk_bf16(a0[2] * bf2f(g.y & 0xffffu), a0[3] * bf2f(g.y >> 16));
      w.z = cvt_pk_bf16(a1[0] * bf2f(g.z & 0xffffu), a1[1] * bf2f(g.z >> 16)); w.w = cvt_pk_bf16(a1[2] * bf2f(g.w & 0xffffu), a1[3] * bf2f(g.w >> 16));
      *(u32x4*)((bf16_t*)(P.ws + WS_MIX) + grow * DM + h * HD + ch * 8) = w;
      if (ch == 0) ((float*)(P.ws + WS_ASS))[grow * NH + h] = ss; }
    __syncthreads();
}
}
__device__ __forceinline__ void phase_attn(const Ptrs& P, int l, unsigned* qctr, volatile LAS unsigned* slot, char* lds, int tid) {
    for (int i = tid; i < 2048 / 4; i += NWAVES * 64) *(unsigned*)(lds + T0_OFF + 4 * i) = ((const unsigned*)(P.ws + WS_T0))[i];
    const float Mb = (prune_thr(P, l, tid & 63) - 40.f) * 0.5f;
    if (tid == 0) *slot = __hip_atomic_fetch_add(qctr, 1u, __ATOMIC_RELAXED, __HIP_MEMORY_SCOPE_AGENT);
    __syncthreads();
    for (;;) {
        const unsigned u = (unsigned)__builtin_amdgcn_readfirstlane((int)*slot);
        if (u >= (unsigned)(DB * NH + NB * NH * 8)) break;
        if (u < (unsigned)(DB * NH)) { sattn::unit(P, l, u >> 3, u & 7, lds, tid);
            if (tid == 0) *slot = __hip_atomic_fetch_add(qctr, 1u, __ATOMIC_RELAXED, __HIP_MEMORY_SCOPE_AGENT);
            __syncthreads(); continue; }
        const unsigned v = u - DB * NH; int bh, qb;
        if (v < 1024u) { bh = v >> 2; qb = 7 - (v & 3); } else { bh = (v - 1024u) >> 2; qb = 3 - (v & 3); }
        const int T0 = __builtin_amdgcn_readfirstlane((int)*(const unsigned char*)(lds + T0_OFF + bh * 8 + qb));
        attn::attn_unit<8>(P, l, bh >> 3, bh & 7, qb, T0, Mb, qctr, slot, lds, tid);
    }
    __syncthreads();
}

#define XB_TMO      128
#define XB_XCNT(j)  (256  + 64 * (j))
#define XB_XSUB(j)  (1280 + 64 * (j))
#define XB_XGEN(j)  (2304 + 64 * (j))
#define XB_TOP      3328
#define XB_TOPGEN   3392
#define XCD_BAR_WORDS 3456
#define XB_SPIN_CAP (1u << 18)

__device__ __forceinline__ unsigned xb_ld(unsigned* p)              { return __hip_atomic_load(p, __ATOMIC_RELAXED, __HIP_MEMORY_SCOPE_AGENT); }
__device__ __forceinline__ unsigned xb_add(unsigned* p, unsigned v) { return __hip_atomic_fetch_add(p, v, __ATOMIC_RELAXED, __HIP_MEMORY_SCOPE_AGENT); }
__device__ __forceinline__ unsigned xb_xcc_id() { return (unsigned)__builtin_amdgcn_s_getreg((3 << 11) | 20) & 0xFu; }
#define XB_SPIN(cond, bar) do { unsigned _sp = 0; while (cond) { __builtin_amdgcn_s_sleep(1); \
    if ((++_sp & 255u) == 0u) { if (xb_ld(&(bar)[XB_TMO])) break; if (_sp > XB_SPIN_CAP) { atomicAdd(&(bar)[XB_TMO], 1u); break; } } } } while (0)

struct XcdBarrier {
    unsigned* bar; unsigned x;
    volatile LAS unsigned* st;
};

__device__ __forceinline__ XcdBarrier xcd_barrier_post(unsigned* bar, volatile LAS unsigned* st) {
    XcdBarrier b; b.bar = bar; b.x = xb_xcc_id(); b.st = st;
    if (threadIdx.x == 0) (void)xb_add(&bar[XB_XCNT(b.x)], 1u);
    return b;
}
__device__ __forceinline__ void xcd_barrier_complete(unsigned* bar, unsigned x, unsigned& nloc, unsigned& nx) {
    const unsigned G = gridDim.x * gridDim.y * gridDim.z;
    unsigned sum, cnt, mine, sp = 0u;
    for (;;) {
        sum = 0u; cnt = 0u; mine = 0u;
#pragma unroll
        for (unsigned j = 0; j < 16; ++j) { const unsigned c = xb_ld(&bar[XB_XCNT(j)]); sum += c; cnt += (c > 0u) ? 1u : 0u; mine = (j == x) ? c : mine; }
        if (sum == G) break;
        __builtin_amdgcn_s_sleep(1);
        if ((++sp & 255u) == 0u) { if (xb_ld(&bar[XB_TMO])) break; if (sp > XB_SPIN_CAP) { atomicAdd(&bar[XB_TMO], 1u); break; } }
    }
    nloc = mine > 0u ? mine : 1u; nx = cnt > 0u ? cnt : 1u;
}

__device__ __forceinline__ void xcd_barrier(const XcdBarrier& b) {
    asm volatile("s_waitcnt vmcnt(0)" ::: "memory");
    __syncthreads();
    if (threadIdx.x == 0) {
        unsigned* bar = b.bar;
        __builtin_amdgcn_s_waitcnt(0);
        unsigned nloc = b.st[0], nx = b.st[1];
        if (nloc == 0u) { xcd_barrier_complete(bar, b.x, nloc, nx); b.st[0] = nloc; b.st[1] = nx; }
        const unsigned old = xb_add(&bar[XB_XSUB(b.x)], 1u);
        const unsigned gen = old / nloc;
        if (old + 1u == (gen + 1u) * nloc) {
            __builtin_amdgcn_fence(__ATOMIC_RELEASE, "agent");
            asm volatile("s_waitcnt vmcnt(0)" ::: "memory");
            const unsigned og = xb_add(&bar[XB_TOP], 1u);
            const unsigned tg = og / nx;
            if (og + 1u == (tg + 1u) * nx) xb_add(&bar[XB_TOPGEN], 1u);
            else XB_SPIN(xb_ld(&bar[XB_TOPGEN]) == tg, bar);
            __builtin_amdgcn_fence(__ATOMIC_ACQUIRE, "agent");
            xb_add(&bar[XB_XGEN(b.x)], 1u);
            asm volatile("s_waitcnt vmcnt(0)" ::: "memory");
        } else {
            XB_SPIN(xb_ld(&bar[XB_XGEN(b.x)]) == gen, bar);
            __builtin_amdgcn_fence(__ATOMIC_ACQUIRE, "agent");
            asm volatile("s_waitcnt vmcnt(0)" ::: "memory");
        }
    }
    __syncthreads();
}

__device__ __forceinline__ void sample_outproj(const Ptrs& P, int l, int t0, int t1, int rank, int nranks, char* shm, int tid) {
    const int lane = tid & 63, wid = __builtin_amdgcn_readfirstlane(tid >> 6), fr = lane & 15, fq = lane >> 4;
    const bf16_t* W = (const bf16_t*)(P.ws + WS_WOUTT) + (size_t)l * DM * DM; const bf16_t* A = (const bf16_t*)(P.ws + WS_MIX);
    for (int tix = t0 + rank; tix < t1; tix += nranks) {
        const int row0 = NPR + 64 * (tix >> 4), col0 = 64 * (tix & 15), k0 = 128 * wid;
        bf16x8 wf[4][4], af[4][4];
#pragma unroll
        for (int nb = 0; nb < 4; ++nb) { const int c = col0 + 16 * nb + fr, i2 = c & 31, pr = (c & ~31) + 16 * ((i2 >> 2) & 1) + 4 * (i2 >> 3) + (i2 & 3);
#pragma unroll
            for (int ks = 0; ks < 4; ++ks) wf[nb][ks] = *(const bf16x8*)(W + (size_t)pr * DM + k0 + 32 * ks + 8 * fq); }
#pragma unroll
        for (int mb = 0; mb < 4; ++mb)
#pragma unroll
            for (int ks = 0; ks < 4; ++ks) af[mb][ks] = *(const bf16x8*)(A + (size_t)(row0 + 16 * mb + fr) * DM + k0 + 32 * ks + 8 * fq);
        f32x4 acc[4][4];
#pragma unroll
        for (int mb = 0; mb < 4; ++mb)
#pragma unroll
            for (int nb = 0; nb < 4; ++nb) acc[mb][nb] = (f32x4){0.f, 0.f, 0.f, 0.f};
#pragma unroll
        for (int ks = 0; ks < 4; ++ks)
#pragma unroll
            for (int mb = 0; mb < 4; ++mb)
#pragma unroll
                for (int nb = 0; nb < 4; ++nb) acc[mb][nb] = __builtin_amdgcn_mfma_f32_16x16x32_bf16(wf[nb][ks], af[mb][ks], acc[mb][nb], 0, 0, 0);
        float* part = (float*)shm + wid * 4096;
#pragma unroll
        for (int mb = 0; mb < 4; ++mb)
#pragma unroll
            for (int nb = 0; nb < 4; ++nb) *(f32x4*)(part + (16 * mb + fr) * 64 + 16 * nb + 4 * fq) = acc[mb][nb];
        __syncthreads();
        { const int rowl = tid >> 3, cc = (tid & 7) * 8, row = row0 + rowl;
          const float* as = (const float*)(P.ws + WS_ASS) + (size_t)row * 8; float sa = 0.f;
#pragma unroll
          for (int i = 0; i < 8; ++i) sa += as[i];
          const float ra = rsqrtf(sa * (1.f / ATT) + EPS), rc = ((const float*)(P.ws + WS_RC))[row];
          f32x4 s0 = (f32x4){0.f, 0.f, 0.f, 0.f}, s1 = s0, t0 = s0, t1 = s0;
#pragma unroll
          for (int w = 0; w < 4; ++w) { const float* p = (const float*)shm + w * 4096 + rowl * 64 + cc; s0 += *(const f32x4*)p; s1 += *(const f32x4*)(p + 4);
              const float* q = p + 4 * 4096; t0 += *(const f32x4*)q; t1 += *(const f32x4*)(q + 4); }
          bf16_t* xb = (bf16_t*)(P.ws + WS_XB) + (size_t)row * DM + col0 + cc; const u32x4 t = *(const u32x4*)xb;
          const f32x4 o0 = (f32x4){bf2f(t.x & 0xffffu), bf2f(t.x >> 16), bf2f(t.y & 0xffffu), bf2f(t.y >> 16)} + s0 * ra + t0 * rc;
          const f32x4 o1 = (f32x4){bf2f(t.z & 0xffffu), bf2f(t.z >> 16), bf2f(t.w & 0xffffu), bf2f(t.w >> 16)} + s1 * ra + t1 * rc;
          if (l == 0) { u32x4 w; w.x = cvt_pk_bf16(o0[0], o0[1]); w.y = cvt_pk_bf16(o0[2], o0[3]); w.z = cvt_pk_bf16(o1[0], o1[1]); w.w = cvt_pk_bf16(o1[2], o1[3]); *(u32x4*)xb = w; }
          else { float* op = P.out + OFF_YS + (size_t)(row - NPR) * DM + col0 + cc; *(f32x4*)op = o0; *(f32x4*)(op + 4) = o1; } }
        __syncthreads();
    }
}

#ifndef PROBE_NOSAMPLE
#define PROBE_NOSAMPLE 0
#endif
#ifndef PROBE_AT
#define PROBE_AT 0
#define PROBE_EXTRA 0
#endif
enum { PH_PREP = 0, PH_X = 1, PH_A = 2, PH_B = 3, PH_C = 4, PH_PER_LAYER = 4, PH_END = 1 + 2 * PH_PER_LAYER };
struct Args { Ptrs P; int ph_lo, ph_hi, opt_bs, use_cg; };
__global__ void __launch_bounds__(NWAVES * 64, 2) fwd_mega(Args args) {
    extern __shared__ __attribute__((aligned(16))) unsigned char lds_raw[];
    LAS unsigned char* lds = (LAS unsigned char*)lds_raw;
    const Ptrs& P = args.P;
    const int G = gridDim.x, bx = blockIdx.x, vcu = (G % 8 == 0) ? (bx % 8) * (G / 8) + bx / 8 : bx;
    const int grp = (bx >> 5) & 1, rank = (bx & 31) | ((bx >> 6) << 5);
    const int wave0 = __builtin_amdgcn_readfirstlane(threadIdx.x >> 6);
    volatile LAS unsigned* bst = (volatile LAS unsigned*)(lds + BST_OFF);
    if (threadIdx.x < 8) bst[threadIdx.x] = 0u;
    unsigned* barw = (unsigned*)(args.P.ws + WS_CTL);
    __syncthreads();
    XcdBarrier xbar = xcd_barrier_post(barw, bst);
    bool first = true;
    for (int st = args.ph_lo; st < args.ph_hi + PROBE_EXTRA; ++st) {
        const int ph = (PROBE_EXTRA && st > PROBE_AT) ? st - PROBE_EXTRA : st;
        if (ph == 1) continue;
        if (!first) { if (args.use_cg) cooperative_groups::this_grid().sync(); else xcd_barrier(xbar); }
        first = false;
        int lane_id; asm volatile("v_mbcnt_lo_u32_b32 %0, -1, 0\n\tv_mbcnt_hi_u32_b32 %0, -1, %0" : "=v"(lane_id));
        const int tid = wave0 * 64 + lane_id;
        const int lane = tid & 63, wave = wave0;
        const int gw = vcu * NWAVES + wave, NGW = G * NWAVES;
        if (ph == PH_PREP) { phase_prep(P, lds, gw, NGW, lane, wave); __syncthreads(); phase_x<0>(P, gw, NGW, lane); continue; }
        const int l = (ph - 1) / PH_PER_LAYER, k = (ph - 1) % PH_PER_LAYER + 1;
        if (k == PH_X) phase_x<1>(P, gw, NGW, lane);
        else if (k == PH_A) {
            const int srank = ((bx >> 6) - 1) * 32 + (bx & 31);
            if (!grp && bx >= 64) phase_scan(P, l, 0, 192, srank, 96, tid, lds);
            pg8::Gemm g{(const bf16_t*)(P.ws + WS_XB), (const bf16_t*)(P.ws + WS_WINT) + (size_t)l * 4096 * DM, NROW, 4096, DM};
            pg8::StaticOrder S; S.init(NROW, 4096, G, bx);
            { LAS float* glw = (LAS float*)(lds + TAB_OFF + 4096);
              { const float* cwp = P.conv_w + (size_t)l * 3 * CONV + tid;
                const float c0 = cwp[0], c1 = cwp[512], c2 = cwp[1024]; float g = 0.f;
                if (tid < 2 * HD) g = tid < HD ? P.q_g[l * HD + tid] * C2 : P.k_g[l * HD + tid - HD];
                glw[2 * HD + tid] = c0; glw[2 * HD + 512 + tid] = c1; glw[2 * HD + 1024 + tid] = c2; if (tid < 2 * HD) glw[tid] = g; }
              __syncthreads(); }
            EpiA E{P, l, (LAS float*)(lds + TAB_OFF), (const LAS float*)(lds + TAB_OFF + 4096)};
            pg8::gemm_phase<EpiA, pg8::StaticOrder, true, true>(lds, g, S, E, tid);
            if (grp && bx >= 64) phase_scan(P, l, 192, NB * NH + DB * NH, srank, 96, tid, lds);
        } else if (k == PH_B) { phase_fix(P, l, gw, NGW, lane); phase_attn(P, l, barw + 4096 + 64 * (l + 2 * (st - ph)), bst + 4, (char*)lds_raw, tid); }
        else {
            pg8::Gemm g{(const bf16_t*)(P.ws + WS_MIX), (const bf16_t*)(P.ws + WS_WOUTT) + (size_t)l * DM * DM, NROW, DM, DM};
            if (!grp) sample_outproj(P, l, 0, 128, rank, G / 2, (char*)lds_raw, tid);
            pg8::StaticOrder S; S.init(NPR, DM, G, bx);
            EpiC E{P, l, (LAS f32x2*)(lds + TAB_OFF)};
            pg8::gemm_phase<EpiC, pg8::StaticOrder, true, true>(lds, g, S, E, tid);
            if (grp) sample_outproj(P, l, 128, 256, rank, G / 2, (char*)lds_raw, tid);
        }
    }
}

extern "C" void kernel_launch(void* const* d_in, const int* in_sizes, int n_in, void* d_out, int out_size, void* d_ws, size_t ws_size, hipStream_t stream) {
    if (n_in != 15 || (size_t)out_size != OUT_TOTAL || ws_size < WS_END) { fprintf(stderr, "kernel_launch: unexpected sizes n_in %d out %d ws %zu\n", n_in, out_size, ws_size); return; }
    static int grid = 0;
    if (grid == 0) {
        int dev = 0, cus = 0, per_cu = 0;
        (void)hipGetDevice(&dev); (void)hipDeviceGetAttribute(&cus, hipDeviceAttributeMultiprocessorCount, dev);
        (void)hipFuncSetAttribute((const void*)fwd_mega, hipFuncAttributeMaxDynamicSharedMemorySize, LDS_BYTES);
        if (hipOccupancyMaxActiveBlocksPerMultiprocessor(&per_cu, (const void*)fwd_mega, NWAVES * 64, LDS_BYTES) != hipSuccess || per_cu < 1) per_cu = 1;
        grid = cus * per_cu;
        fprintf(stderr, "kernel_launch: grid %d (cus %d x %d per cu)\n", grid, cus, per_cu);
        if (grid != 256) { fprintf(stderr, "kernel_launch: this build's tile orders assume 256 resident workgroups (got %d); nothing launched\n", grid); grid = -1; }
    }
    if (grid < 0) return;
    Args a{};
    a.P.x_prompt = (const float*)d_in[0]; a.P.x_sample = (const float*)d_in[1]; a.P.cache_k = (const float*)d_in[2]; a.P.cache_v = (const float*)d_in[3];
    a.P.cache_logf = (const float*)d_in[4]; a.P.state_conv = (const float*)d_in[5]; a.P.norm_g = (const float*)d_in[6]; a.P.w_in = (const float*)d_in[7];
    a.P.b_f = (const float*)d_in[8]; a.P.q_g = (const float*)d_in[9]; a.P.k_g = (const float*)d_in[10]; a.P.conv_w = (const float*)d_in[11];
    a.P.att_g = (const float*)d_in[12]; a.P.conv_g = (const float*)d_in[13]; a.P.w_out = (const float*)d_in[14];
    a.P.out = (float*)d_out; a.P.ws = (unsigned char*)d_ws;
    a.ph_lo = 0; a.ph_hi = PH_END; a.opt_bs = 1; a.use_cg = 0;
    if (hipMemsetAsync((char*)d_ws + WS_CTL, 0, 65536, stream) != hipSuccess) { fprintf(stderr, "kernel_launch: hipMemsetAsync of the control words failed\n"); return; }
    void* kargs[] = {&a};
    const hipError_t e = hipLaunchCooperativeKernel((const void*)fwd_mega, dim3(grid), dim3(NWAVES * 64), kargs, LDS_BYTES, stream);
    if (e != hipSuccess) fprintf(stderr, "kernel_launch: cooperative launch failed: %s (grid %d)\n", hipGetErrorString(e), grid);
}
```
